# Optimizing an MI355X kernel written in HIP

```python
import jax, jax.numpy as jnp
from jax import lax
import numpy as np

D_MODEL = 1024
BATCH = 4
SEQ = 4096
DEPTH = 2

HEAD_DIM = 64
CONV_CH = D_MODEL // 4
FOX_HEADS = (D_MODEL // 4) // HEAD_DIM
DIL_HEADS = (D_MODEL // 2) // HEAD_DIM
FOX_W = FOX_HEADS * HEAD_DIM
DIL_W = DIL_HEADS * HEAD_DIM
CONV_K = 31
DIL_CONFIGS = ((128, 1), (512, 4), (2048, 16))
BLK = 128
ROPE_THETA = 10000.0
D_FF = 2816
ALPHA = (2 * DEPTH) ** 0.25
BETA = (8 * DEPTH) ** -0.25
LN_EPS = 1e-5
FORGET_BIAS_CENTER = 3.0
IN_WIDTHS = (CONV_CH, CONV_CH, FOX_W, FOX_W, FOX_W, FOX_HEADS, DIL_W, DIL_W, DIL_W)
IN_COLS = sum(IN_WIDTHS)
SPLIT_POINTS = tuple(int(v) for v in np.cumsum(IN_WIDTHS)[:-1])

kernel_name = "hymba_style_conv_fox_dilated_deepnorm"


def layer_norm(x, g, b):
    xf = x.astype(jnp.float32)
    mu = jnp.mean(xf, axis=-1, keepdims=True)
    var = jnp.mean(jnp.square(xf - mu), axis=-1, keepdims=True)
    return ((xf - mu) * lax.rsqrt(var + LN_EPS)).astype(x.dtype) * g + b


def swiglu_ffn(x, w_in, w_out):
    gate, up = jnp.split(x @ w_in, 2, axis=-1)
    return (jax.nn.silu(gate) * up) @ w_out


def rope(t, positions):
    inv = 1.0 / (ROPE_THETA ** (jnp.arange(0, HEAD_DIM, 2, dtype=jnp.float32) / HEAD_DIM))
    ang = positions.astype(jnp.float32)[:, None] * inv[None, :]
    ang = jnp.concatenate([ang, ang], axis=-1)
    cos = jnp.cos(ang).astype(t.dtype)
    sin = jnp.sin(ang).astype(t.dtype)
    t1, t2 = jnp.split(t, 2, axis=-1)
    return t * cos + jnp.concatenate([-t2, t1], axis=-1) * sin


def conv_module(val, gate, conv_w, conv_b, g, b):
    u = val * jax.nn.sigmoid(gate)
    u = lax.conv_general_dilated(
        u, conv_w[:, None, :].astype(u.dtype), window_strides=(1,),
        padding=[(CONV_K - 1, 0)], dimension_numbers=('NWC', 'WIO', 'NWC'),
        feature_group_count=CONV_CH) + conv_b
    return jax.nn.silu(layer_norm(u, g, b))


def forgetting_attention(q, k, v, f_logit, f_bias):
    bsz, nh, s_len, dh = q.shape
    log_f = jax.nn.log_sigmoid((f_logit + f_bias).astype(jnp.float32))
    cum = jnp.cumsum(log_f, axis=1).transpose(0, 2, 1)
    nq = s_len // BLK
    qb = q.reshape(bsz, nh, nq, BLK, dh).transpose(2, 0, 1, 3, 4)
    cb = cum.reshape(bsz, nh, nq, BLK).transpose(2, 0, 1, 3)
    kpos = jnp.arange(s_len)
    scale = HEAD_DIM ** -0.5

    def block(args):
        qi, ci, start = args
        s = jnp.einsum('bhqe,bhke->bhqk', qi, k).astype(jnp.float32) * scale
        s = s + (ci[..., :, None] - cum[..., None, :])
        qpos = start + jnp.arange(BLK)
        s = jnp.where(kpos[None, :] <= qpos[:, None], s, -jnp.inf)
        p = jax.nn.softmax(s, axis=-1)
        return jnp.einsum('bhqk,bhke->bhqe', p.astype(v.dtype), v)

    out = lax.map(block, (qb, cb, jnp.arange(nq) * BLK))
    return out.transpose(1, 2, 0, 3, 4).reshape(bsz, nh, s_len, dh)


def dilated_branch(q, k, v, window, dilation):
    bsz, nh, s_len, dh = q.shape
    span = window // dilation
    seg = dilation * BLK
    s_pad = -(-s_len // seg) * seg
    m_len = s_pad // dilation
    nb = m_len // BLK

    def to_sub(t):
        t = jnp.pad(t, ((0, 0), (0, 0), (0, s_pad - s_len), (0, 0)))
        t = t.reshape(bsz, nh, m_len, dilation, dh).transpose(0, 1, 3, 2, 4)
        return t.reshape(bsz, nh, dilation, nb, BLK, dh)

    def with_prev(t):
        prev = jnp.pad(t, ((0, 0), (0, 0), (0, 0), (1, 0), (0, 0), (0, 0)))[:, :, :, :-1]
        return jnp.concatenate([prev, t], axis=4)

    qs = to_sub(q)
    kw = with_prev(to_sub(k))
    vw = with_prev(to_sub(v))
    s = jnp.einsum('bhrnqe,bhrnke->bhrnqk', qs, kw).astype(jnp.float32)
    qm = jnp.arange(nb)[:, None, None] * BLK + jnp.arange(BLK)[None, :, None]
    km = jnp.arange(nb)[:, None, None] * BLK + jnp.arange(2 * BLK)[None, None, :] - BLK
    dist = qm - km
    valid = (km >= 0) & (dist >= 0) & (dist <= span)
    s = jnp.where(valid, s, -jnp.inf)
    mx = jnp.max(s, axis=-1, keepdims=True)
    p = jnp.exp(s - mx)
    den = jnp.sum(p, axis=-1, keepdims=True)
    o = jnp.einsum('bhrnqk,bhrnke->bhrnqe', (p / den).astype(v.dtype), vw)
    lse = (mx + jnp.log(den))[..., 0]
    o = o.reshape(bsz, nh, dilation, m_len, dh).transpose(0, 1, 3, 2, 4)
    o = o.reshape(bsz, nh, s_pad, dh)[:, :, :s_len]
    lse = lse.reshape(bsz, nh, dilation, m_len).transpose(0, 1, 3, 2)
    lse = lse.reshape(bsz, nh, s_pad)[:, :, :s_len]
    return o, lse


def dilated_attention(q, k, v):
    branches = [dilated_branch(q, k, v, w, d) for w, d in DIL_CONFIGS]
    outs = jnp.stack([o for o, _ in branches], axis=0)
    lses = jnp.stack([l for _, l in branches], axis=0)
    wts = jax.nn.softmax(lses, axis=0)
    return jnp.einsum('nbhs,nbhse->bhse', wts.astype(outs.dtype), outs)


def hybrid_mixer(x, w_in, w_o, f_bias, conv_w, conv_b, conv_g, conv_beta, positions):
    bsz, s_len, _ = x.shape
    proj = x @ w_in
    a_val, a_gate, bq, bk, bv, bf, cq, ck, cv = jnp.split(proj, SPLIT_POINTS, axis=-1)

    def heads(t, nh):
        return t.reshape(bsz, s_len, nh, HEAD_DIM).transpose(0, 2, 1, 3)

    def merge(t):
        return t.transpose(0, 2, 1, 3).reshape(bsz, s_len, -1)

    y_a = conv_module(a_val, a_gate, conv_w, conv_b, conv_g, conv_beta)
    y_b = forgetting_attention(heads(bq, FOX_HEADS), heads(bk, FOX_HEADS),
                               heads(bv, FOX_HEADS), bf, f_bias)
    qc = rope(heads(cq, DIL_HEADS), positions) * (HEAD_DIM ** -0.5)
    kc = rope(heads(ck, DIL_HEADS), positions)
    y_c = dilated_attention(qc, kc, heads(cv, DIL_HEADS))
    y = jnp.concatenate([y_a, merge(y_b), merge(y_c)], axis=-1)
    return y @ w_o


def setup_inputs(seed: int = 0) -> dict:
    key = jax.random.key(seed)
    ks = jax.random.split(key, 12)
    f32 = jnp.float32
    x = jax.random.normal(ks[0], (BATCH, SEQ, D_MODEL), f32)
    w_in = jax.random.normal(ks[1], (DEPTH, D_MODEL, IN_COLS), f32) * D_MODEL ** -0.5
    w_o = jax.random.normal(ks[2], (DEPTH, D_MODEL, D_MODEL), f32) * (D_MODEL ** -0.5) * BETA
    forget_bias = FORGET_BIAS_CENTER + 0.5 * jax.random.normal(ks[3], (DEPTH, FOX_HEADS), f32)
    conv_w = jax.random.normal(ks[4], (DEPTH, CONV_K, CONV_CH), f32) * CONV_K ** -0.5
    conv_b = 0.02 * jax.random.normal(ks[5], (DEPTH, CONV_CH), f32)
    conv_ln_g = 1.0 + 0.02 * jax.random.normal(ks[6], (DEPTH, CONV_CH), f32)
    conv_ln_b = 0.02 * jax.random.normal(ks[7], (DEPTH, CONV_CH), f32)
    ffn_w_in = jax.random.normal(ks[8], (DEPTH, 2, D_MODEL, 2 * D_FF), f32) * D_MODEL ** -0.5
    ffn_w_out = jax.random.normal(ks[9], (DEPTH, 2, D_FF, D_MODEL), f32) * (D_FF ** -0.5) * BETA
    ln_g = 1.0 + 0.02 * jax.random.normal(ks[10], (DEPTH, 3, D_MODEL), f32)
    ln_b = 0.02 * jax.random.normal(ks[11], (DEPTH, 3, D_MODEL), f32)
    return {"x": x, "w_in": w_in, "w_o": w_o, "forget_bias": forget_bias,
            "conv_w": conv_w, "conv_b": conv_b, "conv_ln_g": conv_ln_g,
            "conv_ln_b": conv_ln_b, "ffn_w_in": ffn_w_in, "ffn_w_out": ffn_w_out,
            "ln_g": ln_g, "ln_b": ln_b}


def reference(x, w_in, w_o, forget_bias, conv_w, conv_b, conv_ln_g, conv_ln_b,
              ffn_w_in, ffn_w_out, ln_g, ln_b):
    positions = jnp.arange(x.shape[1])
    h = x
    for l in range(DEPTH):
        h = layer_norm(ALPHA * h + 0.5 * swiglu_ffn(h, ffn_w_in[l, 0], ffn_w_out[l, 0]),
                       ln_g[l, 0], ln_b[l, 0])
        h = layer_norm(ALPHA * h + hybrid_mixer(h, w_in[l], w_o[l], forget_bias[l], conv_w[l],
                                                conv_b[l], conv_ln_g[l], conv_ln_b[l], positions),
                       ln_g[l, 1], ln_b[l, 1])
        h = layer_norm(ALPHA * h + 0.5 * swiglu_ffn(h, ffn_w_in[l, 1], ffn_w_out[l, 1]),
                       ln_g[l, 2], ln_b[l, 2])
    return h
```

```cpp
#include <hip/hip_runtime.h>
#include <hip/hip_cooperative_groups.h>
#include <cstdio>
#include <cstdint>
#include <cmath>
namespace cg = cooperative_groups;
namespace pg8 {
#define PG8_LAS __attribute__((address_space(3)))
typedef unsigned short bf16_t;
typedef short bf16x8 __attribute__((ext_vector_type(8)));
typedef float f32x4 __attribute__((ext_vector_type(4)));
typedef unsigned u32x4 __attribute__((ext_vector_type(4)));
constexpr int BM = 256, BK = 64, HALF = 128, HTB = HALF * BK * 2  , STAGE_BYTES = 8 * HTB, NXCD = 8, WGM = 8;

__host__ __device__ __forceinline__ int lds_byte(int r, int c) { const int st = (r >> 4) * 2 + (c >> 5), rr = r & 15, cc = c & 31, ob = rr * 64 + cc * 2; return st * 1024 + (ob ^ (((ob >> 9) & 1) << 5)); }
__host__ __device__ __forceinline__ void stage_rc(int b, int& R, int& C) { const int st = b / 1024, sb = b % 1024, swz = sb ^ (((sb >> 9) & 1) << 5); R = (st >> 1) * 16 + swz / 64; C = (st & 1) * 32 + (swz % 64) / 2; }
__host__ __device__ __forceinline__ int perm32(int rho) { const int n = rho >> 4, i = rho & 15; return 8 * (i >> 2) + 4 * n + (i & 3); }

struct Unit { int pm, pn; };
struct Gemm { const bf16_t* A; const bf16_t* Bt; int M, N, K; };

struct StaticOrder {
    int nM, nN, nwg, G, c;
    __host__ __device__ void init(int M, int N, int G_, int c_) { nM = M / BM; nN = N / BM; nwg = nM * nN; G = G_; c = c_; }
    __host__ __device__ bool next(int i, Unit& u) const {
        const long L = (long)i * G + c; if (L >= nwg) return false;
        int wgid = (int)L; { const int q = nwg / NXCD, r = nwg % NXCD, xcd = wgid % NXCD, off = wgid / NXCD; wgid = (xcd < r ? xcd * (q + 1) : r * (q + 1) + (xcd - r) * q) + off; }
        const int nig = WGM * nN, gid = wgid / nig, fm = gid * WGM, gsz = (nM - fm) < WGM ? (nM - fm) : WGM;
        u.pm = fm + ((wgid % nig) % gsz); u.pn = (wgid % nig) / gsz; return true;
    }
    __device__ __forceinline__ void a_ready(const Unit&) const {}
    __device__ __forceinline__ void done(const Unit&) const {}
};

__device__ __forceinline__ unsigned cvt_pk_bf16(float lo, float hi) { unsigned r; asm volatile("v_cvt_pk_bf16_f32 %0, %1, %2" : "=v"(r) : "v"(lo), "v"(hi)); return r; }
typedef float f32x2 __attribute__((ext_vector_type(2)));
template <class Epi, class Sched, bool ALIGN_EPI = false, bool SP2 = false>
__device__ __forceinline__ void gemm_phase(PG8_LAS unsigned char* lds, const Gemm g, const Sched& S, const Epi& E) {
    int tid_ = threadIdx.x; asm volatile("" : "+v"(tid_));
    const int tid = tid_, wid = __builtin_amdgcn_readfirstlane(tid >> 6), lane = tid & 63, wr = wid >> 2, wc = wid & 3, fr = lane & 15, fq = lane >> 4;
    const int K = g.K, nt = K / BK;
    unsigned voffA[2], voffB[2];
#pragma unroll
    for (int i = 0; i < 2; ++i) { int R, C; stage_rc(tid * 16 + i * 8192, R, C); const int Rb = Epi::PERM ? ((R & ~31) + perm32(R & 31)) : R;
        voffA[i] = (unsigned)(R * K + C) * 2u; voffB[i] = (unsigned)(Rb * K + C) * 2u; }
    const size_t kstep = (size_t)(BK * 2);
    const size_t hstep = (size_t)HALF * K * 2;
    const size_t tstep = 2 * hstep;
    const unsigned ldsw = (unsigned)wid * 1024u;
    const int aoff = lds_byte(wr * 64 + fr, fq * 8), boff = lds_byte(wc * 32 + fr, fq * 8);
#define PG8_SA(b, h) (((b) * 2 + (h)) * HTB)
#define PG8_SB(b, h) ((4 + (b) * 2 + (h)) * HTB)
#define PG8_STAGE(bufoff, gbase, voff) do { _Pragma("unroll") for (int _i = 0; _i < 2; ++_i) \
        __builtin_amdgcn_global_load_lds((const unsigned*)((const char*)(gbase) + (voff)[_i]), (PG8_LAS unsigned*)(lds + (bufoff) + ldsw + _i * 8192), 16, 0, 0); } while (0)
#define PG8_LDA(dst, b, h) do { _Pragma("unroll") for (int m = 0; m < 4; ++m) _Pragma("unroll") for (int k = 0; k < 2; ++k) dst[m][k] = *(const PG8_LAS bf16x8*)(lds + PG8_SA(b, h) + aoff + m * 2048 + k * 1024); } while (0)
#define PG8_LDB(dst, b, h) do { _Pragma("unroll") for (int n = 0; n < 2; ++n) _Pragma("unroll") for (int k = 0; k < 2; ++k) dst[n][k] = *(const PG8_LAS bf16x8*)(lds + PG8_SB(b, h) + boff + n * 2048 + k * 1024); } while (0)
#define PG8_MMA(ai, bj, At, Bt) do { __builtin_amdgcn_s_setprio(1); _Pragma("unroll") for (int m = 0; m < 4; ++m) _Pragma("unroll") for (int n = 0; n < 2; ++n) _Pragma("unroll") for (int k = 0; k < 2; ++k) \
        acc[ai][bj][m][n] = __builtin_amdgcn_mfma_f32_16x16x32_bf16(Bt[n][k], At[m][k], acc[ai][bj][m][n], 0, 0, 0); __builtin_amdgcn_s_setprio(0); } while (0)
#define PG8_WAIT_V(n) asm volatile("s_waitcnt vmcnt(" #n ")" ::: "memory")
#define PG8_WAIT_L(n) asm volatile("s_waitcnt lgkmcnt(" #n ")" ::: "memory")
#define PG8_BAR __builtin_amdgcn_s_barrier()
#define PG8_SCHED __builtin_amdgcn_sched_barrier(0)
    Unit cur, nxt; int ui = 0;
    if (!S.next(0, cur)) return;
    f32x4 acc[2][2][4][2];
#pragma unroll
    for (int a = 0; a < 2; ++a)
#pragma unroll
        for (int b = 0; b < 2; ++b)
#pragma unroll
            for (int m = 0; m < 4; ++m)
#pragma unroll
                for (int n = 0; n < 2; ++n) acc[a][b][m][n] = (f32x4){0.f, 0.f, 0.f, 0.f};
    bf16x8 At[4][2], B0[2][2], B1[2][2];
    const char* cA = (const char*)g.A + (size_t)cur.pm * tstep; const char* cB = (const char*)g.Bt + (size_t)cur.pn * tstep;
    S.a_ready(cur);
    if constexpr (SP2) {
        PG8_STAGE(PG8_SB(0, 0), cB, voffB); PG8_STAGE(PG8_SB(0, 1), cB + hstep, voffB); PG8_STAGE(PG8_SA(0, 0), cA, voffA); PG8_STAGE(PG8_SA(0, 1), cA + hstep, voffA);
        if (wr == 1) PG8_BAR;
        PG8_WAIT_V(2); PG8_BAR;
        PG8_STAGE(PG8_SB(1, 0), cB + kstep, voffB); PG8_STAGE(PG8_SA(1, 0), cA + kstep, voffA); PG8_STAGE(PG8_SB(1, 1), cB + hstep + kstep, voffB);
        PG8_WAIT_V(6); PG8_BAR;
    } else {
        PG8_STAGE(PG8_SB(0, 0), cB, voffB); PG8_STAGE(PG8_SA(0, 0), cA, voffA); PG8_STAGE(PG8_SB(0, 1), cB + hstep, voffB); PG8_STAGE(PG8_SA(0, 1), cA + hstep, voffA);
        if (wr == 1) PG8_BAR;
        PG8_WAIT_V(4); PG8_BAR;
        PG8_STAGE(PG8_SB(1, 0), cB + kstep, voffB); PG8_STAGE(PG8_SA(1, 0), cA + kstep, voffA); PG8_STAGE(PG8_SB(1, 1), cB + hstep + kstep, voffB);
        PG8_WAIT_V(6); PG8_BAR;
    }
    for (;;) {
        const bool has_next = S.next(ui + 1, nxt);
        const char* nA = has_next ? (const char*)g.A + (size_t)nxt.pm * tstep : cA; const char* nB = has_next ? (const char*)g.Bt + (size_t)nxt.pn * tstep : cB;
        for (int t = 0; t < nt; t += 2) {
            const bool last = (t == nt - 2);
            const char* a1 = cA + (size_t)(t + 1) * kstep;
            const char* a2 = last ? nA : cA + (size_t)(t + 2) * kstep; const char* b2 = last ? nB : cB + (size_t)(t + 2) * kstep;
            const char* a3 = a2 + kstep; const char* b3 = b2 + kstep;
            if (last && has_next) S.a_ready(nxt);
            if constexpr (SP2) {
            PG8_LDB(B0, 0, 0); PG8_LDB(B1, 0, 1); PG8_SCHED; PG8_LDA(At, 0, 0); PG8_STAGE(PG8_SA(1, 1), a1 + hstep, voffA);
            PG8_WAIT_V(8); PG8_WAIT_L(0); PG8_BAR; PG8_MMA(0, 0, At, B0); PG8_MMA(0, 1, At, B1); PG8_BAR; PG8_SCHED;
            PG8_LDA(At, 0, 1); PG8_STAGE(PG8_SB(0, 0), b2, voffB); PG8_STAGE(PG8_SB(0, 1), b2 + hstep, voffB); PG8_STAGE(PG8_SA(0, 0), a2, voffA);
            PG8_WAIT_V(8); PG8_WAIT_L(0); PG8_BAR; PG8_MMA(1, 0, At, B0); PG8_MMA(1, 1, At, B1); PG8_BAR; PG8_SCHED;
            PG8_LDB(B0, 1, 0); PG8_LDB(B1, 1, 1); PG8_SCHED; PG8_LDA(At, 1, 0); PG8_STAGE(PG8_SA(0, 1), a2 + hstep, voffA);
            PG8_WAIT_V(8); PG8_WAIT_L(0); PG8_BAR; PG8_MMA(0, 0, At, B0); PG8_MMA(0, 1, At, B1); PG8_BAR; PG8_SCHED;
            PG8_LDA(At, 1, 1); PG8_STAGE(PG8_SB(1, 0), b3, voffB); PG8_STAGE(PG8_SB(1, 1), b3 + hstep, voffB); PG8_STAGE(PG8_SA(1, 0), a3, voffA);
            PG8_WAIT_V(8); PG8_WAIT_L(0); PG8_BAR; PG8_MMA(1, 0, At, B0); PG8_MMA(1, 1, At, B1); PG8_BAR; PG8_SCHED;
            } else {
            PG8_LDB(B0, 0, 0); PG8_SCHED; PG8_LDA(At, 0, 0); PG8_STAGE(PG8_SA(1, 1), a1 + hstep, voffA);
            PG8_WAIT_L(8); PG8_BAR; PG8_WAIT_L(0); PG8_MMA(0, 0, At, B0); PG8_BAR; PG8_SCHED;
            PG8_LDB(B1, 0, 1); PG8_STAGE(PG8_SB(0, 0), b2, voffB);
            PG8_BAR; PG8_WAIT_L(0); PG8_MMA(0, 1, At, B1); PG8_BAR;
            PG8_LDA(At, 0, 1); PG8_STAGE(PG8_SA(0, 0), a2, voffA);
            PG8_BAR; PG8_WAIT_L(0); PG8_MMA(1, 0, At, B0); PG8_BAR; PG8_SCHED;
            PG8_STAGE(PG8_SB(0, 1), b2 + hstep, voffB);
            PG8_WAIT_V(6); PG8_BAR; PG8_MMA(1, 1, At, B1); PG8_BAR;
            PG8_LDB(B0, 1, 0); PG8_SCHED; PG8_LDA(At, 1, 0); PG8_STAGE(PG8_SA(0, 1), a2 + hstep, voffA);
            PG8_WAIT_L(8); PG8_BAR; PG8_WAIT_L(0); PG8_MMA(0, 0, At, B0); PG8_BAR; PG8_SCHED;
            PG8_LDB(B1, 1, 1); PG8_STAGE(PG8_SB(1, 0), b3, voffB);
            PG8_BAR; PG8_WAIT_L(0); PG8_MMA(0, 1, At, B1); PG8_BAR;
            PG8_LDA(At, 1, 1); PG8_STAGE(PG8_SA(1, 0), a3, voffA);
            PG8_BAR; PG8_WAIT_L(0); PG8_MMA(1, 0, At, B0); PG8_BAR; PG8_SCHED;
            PG8_STAGE(PG8_SB(1, 1), b3 + hstep, voffB);
            PG8_WAIT_V(6); PG8_BAR; PG8_MMA(1, 1, At, B1); PG8_BAR;
            }
        }
        if constexpr (ALIGN_EPI) { if (wr == 0) PG8_BAR; }
        if constexpr (!Epi::AFTER_DRAIN) { E(acc, cur, wr, wc, fr, fq); S.done(cur); }
        if (!has_next) break;
#pragma unroll
        for (int a = 0; a < 2; ++a)
#pragma unroll
            for (int b = 0; b < 2; ++b)
#pragma unroll
                for (int m = 0; m < 4; ++m)
#pragma unroll
                    for (int n = 0; n < 2; ++n) acc[a][b][m][n] = (f32x4){0.f, 0.f, 0.f, 0.f};
        cur = nxt; cA = nA; cB = nB; ++ui;
        if constexpr (ALIGN_EPI) { if (wr == 1) PG8_BAR; }
    }
    PG8_WAIT_V(0);
    if constexpr (!ALIGN_EPI) { if (wr == 0) PG8_BAR; }
    PG8_BAR;
    if constexpr (Epi::AFTER_DRAIN) { E.fused(acc, cur, wr, wc, fr, fq, lds, wid, lane); S.done(cur); }
#undef PG8_SA
#undef PG8_SB
#undef PG8_STAGE
#undef PG8_LDA
#undef PG8_LDB
#undef PG8_MMA
#undef PG8_WAIT_V
#undef PG8_WAIT_L
#undef PG8_BAR
#undef PG8_SCHED
}
}

#define LAS __attribute__((address_space(3)))
typedef unsigned short bf16;
typedef short bf16x8 __attribute__((ext_vector_type(8)));
typedef short s16x4 __attribute__((ext_vector_type(4)));
typedef float f32x4 __attribute__((ext_vector_type(4)));
typedef float f32x16 __attribute__((ext_vector_type(16)));
typedef unsigned u32x4 __attribute__((ext_vector_type(4)));
typedef unsigned u32x2 __attribute__((ext_vector_type(2)));
typedef float f32x2_t __attribute__((ext_vector_type(2)));
typedef __bf16 bf16x2_t __attribute__((ext_vector_type(2)));

constexpr int NB = 4, SEQ = 4096, DM = 1024, MTOK = NB * SEQ, DFF = 2816, NPROJ = 2816, INCOLS = 2820;
constexpr float ALPHA = 1.41421356237309515f, LN_EPS = 1e-5f, LOG2E = 1.4426950408889634f;
constexpr size_t MiB = 1u << 20;
constexpr size_t WS_CTL = 0, WS_ROPE = 1 * MiB, WS_W1T = 2 * MiB, WS_W2T = 46 * MiB, WS_WINT = 68 * MiB, WS_WOT = 79 * MiB, WS_HB = 83 * MiB, WS_LGF = 115 * MiB,
                 WS_ACT = 116 * MiB, WS_AV = 116 * MiB, WS_AG = 124 * MiB, WS_BQ = 132 * MiB, WS_BK = 140 * MiB, WS_BVT = 148 * MiB, WS_CQ = 156 * MiB, WS_CK = 172 * MiB,
                 WS_CVT1 = 188 * MiB, WS_CVT4 = 204 * MiB, WS_CVT16 = 220 * MiB, WS_YCAT = 236 * MiB, WS_END = 268 * MiB;
constexpr int LDS_BYTES = 147456, LDS_MISC = 131072;
constexpr int NTHR = 512;

__device__ __forceinline__ unsigned cvtpk(float lo, float hi) { f32x2_t v = {lo, hi}; bf16x2_t b = __builtin_convertvector(v, bf16x2_t); return __builtin_bit_cast(unsigned, b); }
__device__ __forceinline__ unsigned short f2bf(float f) { return (unsigned short)(cvtpk(f, 0.f) & 0xffffu); }
__device__ __forceinline__ float bf2f(unsigned short b) { return __builtin_bit_cast(float, (unsigned)b << 16); }
__device__ __forceinline__ float wave_sum(float v) {
#pragma unroll
    for (int o = 1; o < 64; o <<= 1) v += __shfl_xor(v, o);
    return v;
}
__device__ __forceinline__ float silu_f(float g) { return g * __builtin_amdgcn_rcpf(1.f + __expf(-g)); }
__device__ __forceinline__ float sigmoid_f(float g) { return __builtin_amdgcn_rcpf(1.f + __expf(-g)); }

struct EpiSwiGLU {
    static constexpr bool PERM = true, AFTER_DRAIN = false;
    bf16* O;
    __device__ __forceinline__ void operator()(const pg8::f32x4 (&acc)[2][2][4][2], const pg8::Unit& u, int wr, int wc, int fr, int fq) const {
        const int row0 = u.pm * 256 + wr * 64 + fr, col0 = u.pn * 128 + wc * 32 + 8 * fq;
#pragma unroll
        for (int ai = 0; ai < 2; ++ai)
#pragma unroll
            for (int m = 0; m < 4; ++m) {
                const pg8::f32x4 g0 = acc[ai][0][m][0], g1 = acc[ai][0][m][1], u0 = acc[ai][1][m][0], u1 = acc[ai][1][m][1];
                u32x4 w;
                w.x = pg8::cvt_pk_bf16(silu_f(g0[0]) * u0[0], silu_f(g0[1]) * u0[1]); w.y = pg8::cvt_pk_bf16(silu_f(g0[2]) * u0[2], silu_f(g0[3]) * u0[3]);
                w.z = pg8::cvt_pk_bf16(silu_f(g1[0]) * u1[0], silu_f(g1[1]) * u1[1]); w.w = pg8::cvt_pk_bf16(silu_f(g1[2]) * u1[2], silu_f(g1[3]) * u1[3]);
                *(u32x4*)(O + (size_t)(row0 + ai * 128 + m * 16) * DFF + col0) = w;
            }
    }
};
struct EpiResid {
    static constexpr bool PERM = true, AFTER_DRAIN = false;
    const float* res; float* out; float scale;
    __device__ __forceinline__ void operator()(const pg8::f32x4 (&acc)[2][2][4][2], const pg8::Unit& u, int wr, int wc, int fr, int fq) const {
        const int row0 = u.pm * 256 + wr * 64 + fr, col0 = u.pn * 256 + wc * 32 + 8 * fq;
#pragma unroll
        for (int ai = 0; ai < 2; ++ai)
#pragma unroll
            for (int m = 0; m < 4; ++m)
#pragma unroll
                for (int bj = 0; bj < 2; ++bj) {
                    const size_t off = (size_t)(row0 + ai * 128 + m * 16) * DM + col0 + bj * 128;
                    const f32x4 r0 = *(const f32x4*)(res + off), r1 = *(const f32x4*)(res + off + 4);
                    f32x4 o0, o1;
#pragma unroll
                    for (int e = 0; e < 4; ++e) { o0[e] = ALPHA * r0[e] + scale * acc[ai][bj][m][0][e]; o1[e] = ALPHA * r1[e] + scale * acc[ai][bj][m][1][e]; }
                    *(f32x4*)(out + off) = o0; *(f32x4*)(out + off + 4) = o1;
                }
    }
};
struct EpiProj {
    static constexpr bool PERM = true, AFTER_DRAIN = false;
    bf16 *AV, *AG, *BQ, *BK, *BVT, *CQ, *CK, *CVT1, *CVT4, *CVT16; const float* rope;
    __device__ __forceinline__ void operator()(const pg8::f32x4 (&acc)[2][2][4][2], const pg8::Unit& u, int wr, int wc, int fr, int fq) const {
        const int pn = u.pn;
        const int rbase = u.pm * 256 + wr * 64;
        if (pn <= 3) {
#pragma unroll
            for (int ai = 0; ai < 2; ++ai)
#pragma unroll
                for (int m = 0; m < 4; ++m)
#pragma unroll
                    for (int bj = 0; bj < 2; ++bj) {
                        const int row = rbase + ai * 128 + m * 16 + fr, cl = bj * 128 + wc * 32 + 8 * fq;
                        const pg8::f32x4 v0 = acc[ai][bj][m][0], v1 = acc[ai][bj][m][1];
                        u32x4 w; w.x = pg8::cvt_pk_bf16(v0[0], v0[1]); w.y = pg8::cvt_pk_bf16(v0[2], v0[3]); w.z = pg8::cvt_pk_bf16(v1[0], v1[1]); w.w = pg8::cvt_pk_bf16(v1[2], v1[3]);
                        if (pn <= 1) { bf16* dst = (pn == 0 ? AV : AG) + (size_t)row * 256 + cl; *(u32x4*)dst = w; }
                        else { const int b = row >> 12, s = row & 4095, head = cl >> 6, dd = cl & 63;
                               bf16* dst = (pn == 2 ? BQ : BK) + ((size_t)((b * 4 + head) * 4096 + s)) * 64 + dd; *(u32x4*)dst = w; }
                    }
        } else if (pn == 4) {
#pragma unroll
            for (int ai = 0; ai < 2; ++ai)
#pragma unroll
                for (int m = 0; m < 4; ++m)
#pragma unroll
                    for (int bj = 0; bj < 2; ++bj) {
                        const int row = rbase + ai * 128 + m * 16 + fr, cl = bj * 128 + wc * 32 + 8 * fq;
                        const int b = row >> 12, s = row & 4095, head = cl >> 6, dd = cl & 63;
                        bf16* dst = BVT + ((size_t)((b * 4 + head) * 64 + dd)) * 4096 + s;
#pragma unroll
                        for (int n = 0; n < 2; ++n)
#pragma unroll
                            for (int e = 0; e < 4; ++e) dst[(size_t)(4 * n + e) * 4096] = f2bf(acc[ai][bj][m][n][e]);
                    }
        } else if (pn <= 8) {
            const bool isq = pn <= 6; const float sc = isq ? 0.125f : 1.0f; const int hb = ((pn - 5) & 1) * 4;
            bf16* base = isq ? CQ : CK;
#pragma unroll
            for (int ai = 0; ai < 2; ++ai)
#pragma unroll
                for (int m = 0; m < 4; ++m)
#pragma unroll
                    for (int bj = 0; bj < 2; ++bj) {
                        const int row = rbase + ai * 128 + m * 16 + fr, cl = bj * 128 + wc * 32 + 8 * fq;
                        const int b = row >> 12, s = row & 4095, head = hb + (cl >> 6), dd = cl & 63, i0 = dd >> 1;
                        const f32x4 c4 = *(const f32x4*)(rope + (size_t)s * 32 + i0), s4 = *(const f32x4*)(rope + 4096 * 32 + (size_t)s * 32 + i0);
                        const pg8::f32x4 v0 = acc[ai][bj][m][0], v1 = acc[ai][bj][m][1];
                        u32x4 w;
                        w.x = pg8::cvt_pk_bf16((v0[0] * c4[0] - v0[1] * s4[0]) * sc, (v0[1] * c4[0] + v0[0] * s4[0]) * sc);
                        w.y = pg8::cvt_pk_bf16((v0[2] * c4[1] - v0[3] * s4[1]) * sc, (v0[3] * c4[1] + v0[2] * s4[1]) * sc);
                        w.z = pg8::cvt_pk_bf16((v1[0] * c4[2] - v1[1] * s4[2]) * sc, (v1[1] * c4[2] + v1[0] * s4[2]) * sc);
                        w.w = pg8::cvt_pk_bf16((v1[2] * c4[3] - v1[3] * s4[3]) * sc, (v1[3] * c4[3] + v1[2] * s4[3]) * sc);
                        *(u32x4*)(base + ((size_t)((b * 8 + head) * 4096 + s)) * 64 + dd) = w;
                    }
        } else {
            const int hb = (pn - 9) * 4;
#pragma unroll
            for (int ai = 0; ai < 2; ++ai)
#pragma unroll
                for (int bj = 0; bj < 2; ++bj) {
                    const int cl = bj * 128 + wc * 32 + 8 * fq, head = hb + (cl >> 6), dd = cl & 63;
                    const int row_b = rbase + ai * 128, b = row_b >> 12, sb = row_b & 4095;
                    bf16* p1 = CVT1 + ((size_t)((b * 8 + head) * 64 + dd)) * 4096;
                    bf16* p4 = CVT4 + ((size_t)((b * 8 + head) * 64 + dd)) * 4096;
                    bf16* p16 = CVT16 + ((size_t)((b * 8 + head) * 64 + dd)) * 4096;
#pragma unroll
                    for (int n = 0; n < 2; ++n)
#pragma unroll
                        for (int e = 0; e < 4; ++e) {
                            const size_t co = (size_t)(4 * n + e) * 4096;
                            const float x0 = acc[ai][bj][0][n][e], x1 = acc[ai][bj][1][n][e], x2 = acc[ai][bj][2][n][e], x3 = acc[ai][bj][3][n][e];
                            u32x2 w16; w16.x = pg8::cvt_pk_bf16(x0, x1); w16.y = pg8::cvt_pk_bf16(x2, x3);
                            *(u32x2*)(p16 + co + fr * 256 + (sb >> 4)) = w16;
                            const unsigned short h0 = (unsigned short)(w16.x & 0xffffu), h1 = (unsigned short)(w16.x >> 16), h2 = (unsigned short)(w16.y & 0xffffu), h3 = (unsigned short)(w16.y >> 16);
                            p1[co + sb + fr] = h0; p1[co + sb + 16 + fr] = h1; p1[co + sb + 32 + fr] = h2; p1[co + sb + 48 + fr] = h3;
                            bf16* q4 = p4 + co + (fr & 3) * 1024 + ((sb + fr) >> 2);
                            q4[0] = h0; q4[4] = h1; q4[8] = h2; q4[12] = h3;
                        }
                }
        }
    }
};

struct Args {
    const float *x, *w_in, *w_o, *fbias, *conv_w, *conv_b, *conv_g, *conv_beta, *ffn_w_in, *ffn_w_out, *ln_g, *ln_b;
    float* out; unsigned char* ws;
};

__device__ __forceinline__ int src_col(int mode, int n) {
    if (mode == 1) return ((n & 255) >> 7) * DFF + (n >> 8) * 128 + (n & 127);
    if (mode == 2) { if (n < 1280) return n; const int np = n - 1280; if (np < 1024) { const int p = np & 63; return 1284 + (np & ~63) + (p >> 1) + 32 * (p & 1); } return 1284 + np; }
    return n;
}
__device__ __forceinline__ void transpose_item(const float* __restrict__ W, int K, int Nsrc, bf16* __restrict__ Wt, int mode, int kb, int nb, LAS float* t, int tid) {
    const int k0 = kb * 64, n0 = nb * 64, nl = tid & 63, sc = src_col(mode, n0 + nl);
#pragma unroll
    for (int i = 0; i < 8; ++i) { const int kk = (tid >> 6) + 8 * i; t[kk * 65 + nl] = W[(size_t)(k0 + kk) * Nsrc + sc]; }
    __syncthreads();
    const int n2 = tid >> 3, kc = (tid & 7) * 8;
    u32x4 w;
    w.x = cvtpk(t[(kc + 0) * 65 + n2], t[(kc + 1) * 65 + n2]); w.y = cvtpk(t[(kc + 2) * 65 + n2], t[(kc + 3) * 65 + n2]);
    w.z = cvtpk(t[(kc + 4) * 65 + n2], t[(kc + 5) * 65 + n2]); w.w = cvtpk(t[(kc + 6) * 65 + n2], t[(kc + 7) * 65 + n2]);
    *(u32x4*)(Wt + (size_t)(n0 + n2) * K + k0 + kc) = w;
    __syncthreads();
}
__device__ __forceinline__ void prologue(const Args& a, LAS unsigned char* lds) {
    const int tid = threadIdx.x, G = gridDim.x, bx = blockIdx.x;
    unsigned char* ws = a.ws;
    if (bx == 0 && tid < 64) ((unsigned*)(ws + WS_CTL))[tid] = 0u;
    { float* rc = (float*)(ws + WS_ROPE); float* rs = rc + 4096 * 32;
      for (int i = bx * NTHR + tid; i < 4096 * 32; i += G * NTHR) { const int pos = i >> 5, j = i & 31;
          const float inv = (float)(1.0 / pow(10000.0, (double)(2 * j) / 64.0)); const float ang = (float)pos * inv;
          rc[i] = (float)cos((double)ang); rs[i] = (float)sin((double)ang); } }
    { bf16* hb = (bf16*)(ws + WS_HB);
      for (size_t i = (size_t)bx * NTHR + tid; i < (size_t)MTOK * DM / 8; i += (size_t)G * NTHR) {
          const f32x4 v0 = *(const f32x4*)(a.x + i * 8), v1 = *(const f32x4*)(a.x + i * 8 + 4);
          u32x4 w; w.x = cvtpk(v0[0], v0[1]); w.y = cvtpk(v0[2], v0[3]); w.z = cvtpk(v1[0], v1[1]); w.w = cvtpk(v1[2], v1[3]);
          *(u32x4*)(hb + i * 8) = w; } }
    LAS float* t = (LAS float*)lds;
    constexpr int I1 = 16 * 88, I2 = 44 * 16, I3 = 16 * 44, I4 = 16 * 16, NIT = 4 * I1 + 4 * I2 + 2 * I3 + 2 * I4;
    for (int it = bx; it < NIT; it += G) {
        int r = it;
        if (r < 4 * I1) { const int mi = r / I1, q = r % I1; transpose_item(a.ffn_w_in + (size_t)mi * 1024 * 5632, 1024, 5632, (bf16*)(ws + WS_W1T) + (size_t)mi * 5632 * 1024, 1, q / 88, q % 88, t, tid); continue; }
        r -= 4 * I1;
        if (r < 4 * I2) { const int mi = r / I2, q = r % I2; transpose_item(a.ffn_w_out + (size_t)mi * DFF * 1024, DFF, 1024, (bf16*)(ws + WS_W2T) + (size_t)mi * 1024 * DFF, 0, q / 16, q % 16, t, tid); continue; }
        r -= 4 * I2;
        if (r < 2 * I3) { const int mi = r / I3, q = r % I3; transpose_item(a.w_in + (size_t)mi * 1024 * INCOLS, 1024, INCOLS, (bf16*)(ws + WS_WINT) + (size_t)mi * NPROJ * 1024, 2, q / 44, q % 44, t, tid); continue; }
        r -= 2 * I3;
        { const int mi = r / I4, q = r % I4; transpose_item(a.w_o + (size_t)mi * 1024 * 1024, 1024, 1024, (bf16*)(ws + WS_WOT) + (size_t)mi * 1024 * 1024, 0, q / 16, q % 16, t, tid); }
    }
}

__device__ __forceinline__ void ln_phase(float* Y, bf16* HB, const float* __restrict__ g, const float* __restrict__ bt, bool fgate, const float* __restrict__ w_in_l,
                                         const float* __restrict__ fbias, float* lgf, LAS unsigned char* lds) {
    int tid_ = threadIdx.x; asm volatile("" : "+v"(tid_));
    const int tid = tid_, lane = tid & 63, wid = tid >> 6, G = gridDim.x;
    LAS f32x4* wf = (LAS f32x4*)lds;
    if (fgate) { for (int k = tid; k < 1024; k += NTHR) wf[k] = *(const f32x4*)(w_in_l + (size_t)k * INCOLS + 1280); }
    __syncthreads();
    f32x4 gv[4], bv[4];
#pragma unroll
    for (int j = 0; j < 4; ++j) { gv[j] = *(const f32x4*)(g + 256 * j + 4 * lane); bv[j] = *(const f32x4*)(bt + 256 * j + 4 * lane); }
    for (int row = blockIdx.x * 8 + wid; row < MTOK; row += G * 8) {
        float* yr = Y + (size_t)row * DM;
        f32x4 v[4]; float s = 0.f;
#pragma unroll
        for (int j = 0; j < 4; ++j) { v[j] = *(const f32x4*)(yr + 256 * j + 4 * lane); s += (v[j][0] + v[j][1]) + (v[j][2] + v[j][3]); }
        const float mean = wave_sum(s) * (1.f / DM); float s2 = 0.f;
#pragma unroll
        for (int j = 0; j < 4; ++j) { v[j] = v[j] - mean; s2 += (v[j][0] * v[j][0] + v[j][1] * v[j][1]) + (v[j][2] * v[j][2] + v[j][3] * v[j][3]); }
        const float rstd = 1.0f / sqrtf(wave_sum(s2) * (1.f / DM) + LN_EPS);
        f32x4 z = {0.f, 0.f, 0.f, 0.f};
#pragma unroll
        for (int j = 0; j < 4; ++j) {
            f32x4 o;
#pragma unroll
            for (int e = 0; e < 4; ++e) o[e] = v[j][e] * rstd * gv[j][e] + bv[j][e];
            *(f32x4*)(yr + 256 * j + 4 * lane) = o;
            u32x2 w; w.x = cvtpk(o[0], o[1]); w.y = cvtpk(o[2], o[3]);
            *(u32x2*)(HB + (size_t)row * DM + 256 * j + 4 * lane) = w;
            if (fgate) {
#pragma unroll
                for (int e = 0; e < 4; ++e) { const f32x4 wv = wf[256 * j + 4 * lane + e]; z = z + wv * o[e]; }
            }
        }
        if (fgate) {
            z[0] = wave_sum(z[0]); z[1] = wave_sum(z[1]); z[2] = wave_sum(z[2]); z[3] = wave_sum(z[3]);
            if (lane < 4) { const float zz = (lane == 0 ? z[0] : lane == 1 ? z[1] : lane == 2 ? z[2] : z[3]) + fbias[lane];
                const float ls = fminf(zz, 0.f) - log1pf(expf(-fabsf(zz)));
                lgf[(size_t)(((row >> 12) * 4 + lane)) * 4096 + (row & 4095)] = ls; }
        }
    }
    __syncthreads();
}

#define MFMA32(a, b, c) __builtin_amdgcn_mfma_f32_32x32x16_bf16((a), (b), (c), 0, 0, 0)
__device__ __forceinline__ bf16x8 pack8(const f32x16& x, int s) {
    u32x4 p; p.x = cvtpk(x[8 * s + 0], x[8 * s + 1]); p.y = cvtpk(x[8 * s + 2], x[8 * s + 3]); p.z = cvtpk(x[8 * s + 4], x[8 * s + 5]); p.w = cvtpk(x[8 * s + 6], x[8 * s + 7]);
    return __builtin_bit_cast(bf16x8, p);
}
constexpr int FK_OFF = 0, FV_OFF = 18432, FCUM_OFF = 36864, FSCR_OFF = 53248, KV_PITCH = 144;

__device__ __forceinline__ void fox_unit(LAS unsigned char* lds, int b, int head, int qb, const bf16* __restrict__ BQ, const bf16* __restrict__ BK, const bf16* __restrict__ BVT,
                                         const float* __restrict__ lgf, bf16* YCAT) {
    int tid_ = threadIdx.x; asm volatile("" : "+v"(tid_));
    const int tid = tid_, lane = tid & 63, wid = tid >> 6, r = lane & 31, h = lane >> 5;
    const int q0 = qb * 256, kend = q0 + 256, ntiles = kend / 64, bh = b * 4 + head;
    LAS float* cum = (LAS float*)(lds + FCUM_OFF); LAS float* scr = (LAS float*)(lds + FSCR_OFF);
    {
        const float* lf = lgf + (size_t)bh * 4096;
        float v[8];
        if (8 * tid < kend) { const f32x4 a0 = *(const f32x4*)(lf + 8 * tid), a1 = *(const f32x4*)(lf + 8 * tid + 4); v[0] = a0[0]; v[1] = a0[1]; v[2] = a0[2]; v[3] = a0[3]; v[4] = a1[0]; v[5] = a1[1]; v[6] = a1[2]; v[7] = a1[3]; }
        else {
#pragma unroll
            for (int j = 0; j < 8; ++j) v[j] = 0.f; }
#pragma unroll
        for (int j = 1; j < 8; ++j) v[j] += v[j - 1];
        const float total = v[7]; float t = total;
#pragma unroll
        for (int o = 1; o < 64; o <<= 1) { const float n = __shfl_up(t, o); if (lane >= o) t += n; }
        if (lane == 63) scr[wid] = t;
        __syncthreads();
        float woff = 0.f;
        for (int w = 0; w < wid; ++w) woff += scr[w];
        const float base = woff + t - total;
#pragma unroll
        for (int j = 0; j < 8; ++j) cum[8 * tid + j] = (base + v[j]) * LOG2E;
    }
    __syncthreads();
    const int qrow = q0 + 32 * wid + r;
    bf16x8 qf[4];
    { const bf16* qp = BQ + ((size_t)bh * 4096 + qrow) * 64 + 8 * h;
#pragma unroll
      for (int ks = 0; ks < 4; ++ks) qf[ks] = *(const bf16x8*)(qp + 16 * ks); }
    const float cq2 = cum[qrow];
    const int my_last = (q0 + 32 * wid + 31) >> 6;
    const float C1 = 0.125f * LOG2E;
    f32x16 o0, o1;
#pragma unroll
    for (int i = 0; i < 16; ++i) { o0[i] = 0.f; o1[i] = 0.f; }
    float m_run = -INFINITY, l_run = 0.f;
    const int srow = tid >> 3, sch = tid & 7;
    const bf16* kg = BK + ((size_t)bh * 4096 + srow) * 64 + sch * 8;
    const bf16* vg = BVT + ((size_t)bh * 64 + srow) * 4096 + sch * 8;
    const int soff = srow * KV_PITCH + sch * 16;
    u32x4 kreg = *(const u32x4*)kg, vreg = *(const u32x4*)vg;
    *(LAS u32x4*)(lds + FK_OFF + soff) = kreg; *(LAS u32x4*)(lds + FV_OFF + soff) = vreg;
    __syncthreads();
    for (int kt = 0; kt < ntiles; ++kt) {
        const int buf = kt & 1;
        if (kt + 1 < ntiles) { kreg = *(const u32x4*)(kg + (size_t)(kt + 1) * 4096); vreg = *(const u32x4*)(vg + (kt + 1) * 64); }
        if (kt <= my_last) {
            LAS unsigned char* Kb = lds + FK_OFF + buf * 9216; LAS unsigned char* Vb = lds + FV_OFF + buf * 9216;
            f32x16 st0, st1;
#pragma unroll
            for (int i = 0; i < 16; ++i) { st0[i] = 0.f; st1[i] = 0.f; }
#pragma unroll
            for (int ks = 0; ks < 4; ++ks) {
                const bf16x8 a0 = *(const LAS bf16x8*)(Kb + r * KV_PITCH + (16 * ks + 8 * h) * 2);
                const bf16x8 a1 = *(const LAS bf16x8*)(Kb + (32 + r) * KV_PITCH + (16 * ks + 8 * h) * 2);
                st0 = MFMA32(a0, qf[ks], st0); st1 = MFMA32(a1, qf[ks], st1);
            }
            const int kbase = kt * 64;
            const bool diag = (kbase + 63) > (q0 + 32 * wid);
            float mx = -INFINITY;
#pragma unroll
            for (int gq = 0; gq < 4; ++gq) {
                const f32x4 c0 = *(const LAS f32x4*)(cum + kbase + 8 * gq + 4 * h), c1 = *(const LAS f32x4*)(cum + kbase + 32 + 8 * gq + 4 * h);
#pragma unroll
                for (int e = 0; e < 4; ++e) {
                    const int i = 4 * gq + e, key0 = kbase + 8 * gq + 4 * h + e;
                    float x0 = st0[i] * C1 + (cq2 - c0[e]), x1 = st1[i] * C1 + (cq2 - c1[e]);
                    if (diag) { if (key0 > qrow) x0 = -INFINITY; if (key0 + 32 > qrow) x1 = -INFINITY; }
                    st0[i] = x0; st1[i] = x1; mx = fmaxf(mx, fmaxf(x0, x1));
                }
            }
            mx = fmaxf(mx, __shfl_xor(mx, 32));
            const float m_new = fmaxf(m_run, mx);
            const float al = exp2f(m_run - m_new);
            float ps = 0.f;
#pragma unroll
            for (int i = 0; i < 16; ++i) { st0[i] = exp2f(st0[i] - m_new); st1[i] = exp2f(st1[i] - m_new); ps += st0[i] + st1[i]; o0[i] *= al; o1[i] *= al; }
            l_run = l_run * al + ps; m_run = m_new;
#pragma unroll
            for (int s2 = 0; s2 < 2; ++s2) {
                const bf16x8 p0 = pack8(st0, s2), p1 = pack8(st1, s2);
#pragma unroll
                for (int ds = 0; ds < 2; ++ds) {
                    const LAS unsigned char* vr = Vb + (32 * ds + r) * KV_PITCH;
                    const s16x4 lo0 = *(const LAS s16x4*)(vr + (16 * s2 + 4 * h) * 2), hi0 = *(const LAS s16x4*)(vr + (16 * s2 + 8 + 4 * h) * 2);
                    const s16x4 lo1 = *(const LAS s16x4*)(vr + (32 + 16 * s2 + 4 * h) * 2), hi1 = *(const LAS s16x4*)(vr + (32 + 16 * s2 + 8 + 4 * h) * 2);
                    const bf16x8 va0 = __builtin_shufflevector(lo0, hi0, 0, 1, 2, 3, 4, 5, 6, 7), va1 = __builtin_shufflevector(lo1, hi1, 0, 1, 2, 3, 4, 5, 6, 7);
                    if (ds == 0) { o0 = MFMA32(va0, p0, o0); o0 = MFMA32(va1, p1, o0); } else { o1 = MFMA32(va0, p0, o1); o1 = MFMA32(va1, p1, o1); }
                }
            }
        }
        if (kt + 1 < ntiles) { *(LAS u32x4*)(lds + FK_OFF + (buf ^ 1) * 9216 + soff) = kreg; *(LAS u32x4*)(lds + FV_OFF + (buf ^ 1) * 9216 + soff) = vreg; }
        __syncthreads();
    }
    const float lt = l_run + __shfl_xor(l_run, 32), inv = 1.0f / lt;
    bf16* yo = YCAT + ((size_t)(b * 4096 + qrow)) * DM + 256 + head * 64 + 4 * h;
#pragma unroll
    for (int gq = 0; gq < 4; ++gq) {
        u32x2 w0, w1;
        w0.x = cvtpk(o0[4 * gq] * inv, o0[4 * gq + 1] * inv); w0.y = cvtpk(o0[4 * gq + 2] * inv, o0[4 * gq + 3] * inv);
        w1.x = cvtpk(o1[4 * gq] * inv, o1[4 * gq + 1] * inv); w1.y = cvtpk(o1[4 * gq + 2] * inv, o1[4 * gq + 3] * inv);
        *(u32x2*)(yo + 8 * gq) = w0; *(u32x2*)(yo + 32 + 8 * gq) = w1;
    }
}

__device__ __forceinline__ void dil_unit(int b, int head, int blk, const bf16* __restrict__ CQ, const bf16* __restrict__ CK, const bf16* __restrict__ CVT1, const bf16* __restrict__ CVT4,
                                         const bf16* __restrict__ CVT16, bf16* YCAT) {
    int tid_ = threadIdx.x; asm volatile("" : "+v"(tid_));
    const int tid = tid_, lane = tid & 63, wid = tid >> 6, r = lane & 31, h = lane >> 5;
    const int t0 = blk * 512, bh = b * 8 + head;
    for (int gi = 0; gi < 2; ++gi) {
        const int rr = 2 * wid + gi, pq = t0 + rr + 16 * r;
        bf16x8 qf[4];
        { const bf16* qp = CQ + ((size_t)bh * 4096 + pq) * 64 + 8 * h;
#pragma unroll
          for (int ks = 0; ks < 4; ++ks) qf[ks] = *(const bf16x8*)(qp + 16 * ks); }
        f32x16 o0, o1;
#pragma unroll
        for (int i = 0; i < 16; ++i) { o0[i] = 0.f; o1[i] = 0.f; }
        float m_run = -INFINITY, l_run = 0.f;
        for (int br = 0; br < 3; ++br) {
            const int lgd = 2 * br, d = 1 << lgd, res = rr & (d - 1), nsubidx = 4096 >> lgd;
            const bf16* VT = (br == 0 ? CVT1 : br == 1 ? CVT4 : CVT16) + (size_t)bh * 64 * 4096 + (size_t)res * nsubidx;
            const int mq0 = (t0 + rr) >> lgd, ms0 = (mq0 - 128) & ~3, last = mq0 + (496 >> lgd), nsub = ((last - ms0) >> 5) + 1;
            const int mq = pq >> lgd;
            for (int sub = 0; sub < nsub; ++sub) {
                const int msk = ms0 + 32 * sub;
                if (msk + 31 < 0) continue;
                int pos = (msk + r) * d + res; pos = pos < 0 ? 0 : (pos > 4095 ? 4095 : pos);
                const bf16* kp = CK + ((size_t)bh * 4096 + pos) * 64 + 8 * h;
                bf16x8 ka[4];
#pragma unroll
                for (int ks = 0; ks < 4; ++ks) ka[ks] = *(const bf16x8*)(kp + 16 * ks);
                bf16x8 va[2][2];
#pragma unroll
                for (int s2 = 0; s2 < 2; ++s2) {
                    int c0 = msk + 16 * s2 + 4 * h, c1 = c0 + 8;
                    c0 = (c0 < 0 || c0 >= nsubidx) ? 0 : c0; c1 = (c1 < 0 || c1 >= nsubidx) ? 0 : c1;
#pragma unroll
                    for (int ds = 0; ds < 2; ++ds) {
                        const bf16* vp = VT + (size_t)(32 * ds + r) * 4096;
                        const s16x4 lo = *(const s16x4*)(vp + c0), hi = *(const s16x4*)(vp + c1);
                        va[s2][ds] = __builtin_shufflevector(lo, hi, 0, 1, 2, 3, 4, 5, 6, 7);
                    }
                }
                f32x16 st;
#pragma unroll
                for (int i = 0; i < 16; ++i) st[i] = 0.f;
#pragma unroll
                for (int ks = 0; ks < 4; ++ks) st = MFMA32(ka[ks], qf[ks], st);
                float mx = -INFINITY;
#pragma unroll
                for (int i = 0; i < 16; ++i) {
                    const int mk = msk + (i & 3) + 8 * (i >> 2) + 4 * h, dist = mq - mk;
                    const bool valid = (mk >= 0) && (dist >= 0) && (dist <= 128);
                    const float x = valid ? st[i] * LOG2E : -INFINITY;
                    st[i] = x; mx = fmaxf(mx, x);
                }
                mx = fmaxf(mx, __shfl_xor(mx, 32));
                const float m_new = fmaxf(m_run, mx);
                const float m_use = (m_new == -INFINITY) ? 0.f : m_new;
                const float al = exp2f(m_run - m_use);
                float ps = 0.f;
#pragma unroll
                for (int i = 0; i < 16; ++i) { st[i] = exp2f(st[i] - m_use); ps += st[i]; o0[i] *= al; o1[i] *= al; }
                l_run = l_run * al + ps; m_run = m_new;
#pragma unroll
                for (int s2 = 0; s2 < 2; ++s2) {
                    const bf16x8 p = pack8(st, s2);
                    o0 = MFMA32(va[s2][0], p, o0); o1 = MFMA32(va[s2][1], p, o1);
                }
            }
        }
        const float lt = l_run + __shfl_xor(l_run, 32), inv = 1.0f / lt;
        bf16* yo = YCAT + ((size_t)(b * 4096 + pq)) * DM + 512 + head * 64 + 4 * h;
#pragma unroll
        for (int gq = 0; gq < 4; ++gq) {
            u32x2 w0, w1;
            w0.x = cvtpk(o0[4 * gq] * inv, o0[4 * gq + 1] * inv); w0.y = cvtpk(o0[4 * gq + 2] * inv, o0[4 * gq + 3] * inv);
            w1.x = cvtpk(o1[4 * gq] * inv, o1[4 * gq + 1] * inv); w1.y = cvtpk(o1[4 * gq + 2] * inv, o1[4 * gq + 3] * inv);
            *(u32x2*)(yo + 8 * gq) = w0; *(u32x2*)(yo + 32 + 8 * gq) = w1;
        }
    }
}

__device__ __forceinline__ void conv_unit(LAS unsigned char* lds, int b, int tile, const bf16* __restrict__ AV, const bf16* __restrict__ AG, const float* __restrict__ cw,
                                          const float* __restrict__ cb, const float* __restrict__ cg_, const float* __restrict__ cbeta, bf16* YCAT) {
    int tid_ = threadIdx.x; asm volatile("" : "+v"(tid_));
    const int tid = tid_, lane = tid & 63, wid = tid >> 6;
    const int t0 = tile * 32;
    LAS float* u = (LAS float*)lds;
    LAS float* co = (LAS float*)(lds + 63488);
    for (int c = tid; c < 62 * 32; c += NTHR) {
        const int tt = c >> 5, ch = (c & 31) * 8, t = t0 - 30 + tt;
        float uv[8];
        if (t >= 0) {
            const size_t off = ((size_t)(b * 4096 + t)) * 256 + ch;
            const u32x4 vv = *(const u32x4*)(AV + off), gg = *(const u32x4*)(AG + off);
#pragma unroll
            for (int j = 0; j < 4; ++j) {
                const unsigned vw = vv[j], gw = gg[j];
                const float v0 = __builtin_bit_cast(float, vw << 16), v1 = __builtin_bit_cast(float, vw & 0xffff0000u);
                const float g0 = __builtin_bit_cast(float, gw << 16), g1 = __builtin_bit_cast(float, gw & 0xffff0000u);
                uv[2 * j] = v0 * sigmoid_f(g0); uv[2 * j + 1] = v1 * sigmoid_f(g1);
            }
        } else {
#pragma unroll
            for (int j = 0; j < 8; ++j) uv[j] = 0.f;
        }
        *(LAS f32x4*)(u + tt * 256 + ch) = (f32x4){uv[0], uv[1], uv[2], uv[3]};
        *(LAS f32x4*)(u + tt * 256 + ch + 4) = (f32x4){uv[4], uv[5], uv[6], uv[7]};
    }
    const int ch = tid & 255, half = tid >> 8;
    float w[31];
#pragma unroll
    for (int k = 0; k < 31; ++k) w[k] = cw[k * 256 + ch];
    const float bias = cb[ch];
    __syncthreads();
    for (int j = 0; j < 16; ++j) {
        const int tl = half * 16 + j;
        float acc = bias;
#pragma unroll
        for (int k = 0; k < 31; ++k) acc += w[k] * u[(tl + k) * 256 + ch];
        co[tl * 256 + ch] = acc;
    }
    __syncthreads();
    const f32x4 gv = *(const f32x4*)(cg_ + 4 * lane), bv = *(const f32x4*)(cbeta + 4 * lane);
#pragma unroll
    for (int j = 0; j < 4; ++j) {
        const int tl = wid * 4 + j;
        f32x4 v = *(const LAS f32x4*)(co + tl * 256 + 4 * lane);
        const float mean = wave_sum((v[0] + v[1]) + (v[2] + v[3])) * (1.f / 256.f);
        v = v - mean;
        const float var = wave_sum((v[0] * v[0] + v[1] * v[1]) + (v[2] * v[2] + v[3] * v[3])) * (1.f / 256.f);
        const float rstd = 1.0f / sqrtf(var + LN_EPS);
        float o[4];
#pragma unroll
        for (int e = 0; e < 4; ++e) o[e] = silu_f(v[e] * rstd * gv[e] + bv[e]);
        u32x2 wv; wv.x = cvtpk(o[0], o[1]); wv.y = cvtpk(o[2], o[3]);
        *(u32x2*)(YCAT + ((size_t)(b * 4096 + t0 + tl)) * DM + 4 * lane) = wv;
    }
    __syncthreads();
}

__global__ void __launch_bounds__(NTHR, 2) hybrid_fwd(Args a) {
    extern __shared__ __attribute__((aligned(16))) unsigned char lds_raw[];
    LAS unsigned char* lds = (LAS unsigned char*)lds_raw;
    cg::grid_group grid = cg::this_grid();
    const int tid = threadIdx.x, G = gridDim.x, bx = blockIdx.x;
    unsigned char* ws = a.ws;
    bf16* HB = (bf16*)(ws + WS_HB); bf16* ACT = (bf16*)(ws + WS_ACT); bf16* YCAT = (bf16*)(ws + WS_YCAT);
    bf16 *AV = (bf16*)(ws + WS_AV), *AG = (bf16*)(ws + WS_AG), *BQ = (bf16*)(ws + WS_BQ), *BK = (bf16*)(ws + WS_BK), *BVT = (bf16*)(ws + WS_BVT), *CQ = (bf16*)(ws + WS_CQ), *CK = (bf16*)(ws + WS_CK),
         *CVT1 = (bf16*)(ws + WS_CVT1), *CVT4 = (bf16*)(ws + WS_CVT4), *CVT16 = (bf16*)(ws + WS_CVT16);
    float* lgf = (float*)(ws + WS_LGF); const float* rope = (const float*)(ws + WS_ROPE);
    unsigned* ctl = (unsigned*)(ws + WS_CTL);
    float* H = a.out;

#ifndef NO_PRO
    prologue(a, lds);
#endif
    grid.sync();

    for (int l = 0; l < 2; ++l) {
        for (int j = 0; j < 3; ++j) {
            if (j != 1) {
                const int fi = l * 2 + (j >> 1);
                {
                    pg8::Gemm g{HB, (const bf16*)(ws + WS_W1T) + (size_t)fi * 5632 * 1024, MTOK, 2 * DFF, DM};
                    pg8::StaticOrder S; S.init(MTOK, 2 * DFF, G, bx);
                    EpiSwiGLU E{ACT};
#ifndef NO_G1
                    pg8::gemm_phase<EpiSwiGLU, pg8::StaticOrder, true, true>(lds, g, S, E);
#endif
                }
                grid.sync();
                {
                    pg8::Gemm g{ACT, (const bf16*)(ws + WS_W2T) + (size_t)fi * 1024 * DFF, MTOK, DM, DFF};
                    pg8::StaticOrder S; S.init(MTOK, DM, G, bx);
                    EpiResid E{(l == 0 && j == 0) ? a.x : (const float*)H, H, 0.5f};
#ifndef NO_G2
                    pg8::gemm_phase<EpiResid, pg8::StaticOrder, true, true>(lds, g, S, E);
#endif
                }
                grid.sync();
            } else {
                {
                    pg8::Gemm g{HB, (const bf16*)(ws + WS_WINT) + (size_t)l * NPROJ * 1024, MTOK, NPROJ, DM};
                    pg8::StaticOrder S; S.init(MTOK, NPROJ, G, bx);
                    EpiProj E{AV, AG, BQ, BK, BVT, CQ, CK, CVT1, CVT4, CVT16, rope};
#ifndef NO_G3
                    pg8::gemm_phase<EpiProj, pg8::StaticOrder, true, true>(lds, g, S, E);
#endif
                }
                grid.sync();
                {
                    LAS int* itemw = (LAS int*)(lds + LDS_MISC);
                    for (;;) {
                        __syncthreads();
                        if (tid == 0) *itemw = (int)atomicAdd(ctl + l, 1u);
                        __syncthreads();
                        const int it = *itemw;
                        if (it >= 1024) break;
                        if (it < 256) { const int qb = 15 - (it >> 4), bhh = it & 15;
#ifndef NO_FOX
 fox_unit(lds, bhh >> 2, bhh & 3, qb, BQ, BK, BVT, lgf, YCAT);
#endif
 }
                        else if (it < 512) { const int q = it - 256;
#ifndef NO_DIL
 dil_unit(q >> 6, (q >> 3) & 7, q & 7, CQ, CK, CVT1, CVT4, CVT16, YCAT);
#endif
 }
                        else { const int q = it - 512;
#ifndef NO_CONV
 conv_unit(lds, q >> 7, q & 127, AV, AG, a.conv_w + (size_t)l * 31 * 256, a.conv_b + l * 256, a.conv_g + l * 256, a.conv_beta + l * 256, YCAT);
#endif
 }
                    }
                }
                grid.sync();
                {
                    pg8::Gemm g{YCAT, (const bf16*)(ws + WS_WOT) + (size_t)l * 1024 * 1024, MTOK, DM, DM};
                    pg8::StaticOrder S; S.init(MTOK, DM, G, bx);
                    EpiResid E{(const float*)H, H, 1.0f};
#ifndef NO_G4
                    pg8::gemm_phase<EpiResid, pg8::StaticOrder, true, true>(lds, g, S, E);
#endif
                }
                grid.sync();
            }
#ifndef NO_LN
            ln_phase(H, HB, a.ln_g + (size_t)(l * 3 + j) * DM, a.ln_b + (size_t)(l * 3 + j) * DM, j == 0, a.w_in + (size_t)l * 1024 * INCOLS, a.fbias + l * 4, lgf, lds);
#endif
            if (!(l == 1 && j == 2)) grid.sync();
        }
    }
}

extern "C" void kernel_launch(void* const* d_in, const int* in_sizes, int n_in, void* d_out, int out_size, void* d_ws, size_t ws_size, hipStream_t stream) {
    static int grid_blocks = 0;
    if (grid_blocks == 0) {
        if (n_in != 12 || out_size != MTOK * DM || ws_size < WS_END) { fprintf(stderr, "kernel_launch: unexpected problem (n_in %d out %d ws %zu)\n", n_in, out_size, ws_size); grid_blocks = -1; return; }
        int dev = 0, cus = 0, per_cu = 0;
        hipGetDevice(&dev);
        hipDeviceGetAttribute(&cus, hipDeviceAttributeMultiprocessorCount, dev);
        if (hipFuncSetAttribute((const void*)hybrid_fwd, hipFuncAttributeMaxDynamicSharedMemorySize, LDS_BYTES) != hipSuccess) { fprintf(stderr, "hipFuncSetAttribute failed\n"); grid_blocks = -1; return; }
        if (hipOccupancyMaxActiveBlocksPerMultiprocessor(&per_cu, (const void*)hybrid_fwd, NTHR, LDS_BYTES) != hipSuccess || per_cu < 1) { fprintf(stderr, "occupancy query failed (%d)\n", per_cu); (void)hipGetLastError(); per_cu = 1; }
        grid_blocks = cus * 1;
    }
    if (grid_blocks < 0) return;
    Args a{};
    a.x = (const float*)d_in[0]; a.w_in = (const float*)d_in[1]; a.w_o = (const float*)d_in[2]; a.fbias = (const float*)d_in[3]; a.conv_w = (const float*)d_in[4]; a.conv_b = (const float*)d_in[5];
    a.conv_g = (const float*)d_in[6]; a.conv_beta = (const float*)d_in[7]; a.ffn_w_in = (const float*)d_in[8]; a.ffn_w_out = (const float*)d_in[9]; a.ln_g = (const float*)d_in[10]; a.ln_b = (const float*)d_in[11];
    a.out = (float*)d_out; a.ws = (unsigned char*)d_ws;
    void* args[] = {&a};
    hipError_t e = hipLaunchCooperativeKernel((const void*)hybrid_fwd, dim3(grid_blocks), dim3(NTHR), args, LDS_BYTES, stream);
    if (e != hipSuccess) fprintf(stderr, "cooperative launch failed: %s (grid %d)\n", hipGetErrorString(e), grid_blocks);
}
```

```cpp
#include <hip/hip_runtime.h>
#include <hip/hip_cooperative_groups.h>
#include <cstdio>
#include <cstdint>
#include <cmath>
namespace cg = cooperative_groups;
namespace pg8 {
#define PG8_LAS __attribute__((address_space(3)))
typedef unsigned short bf16_t;
typedef short bf16x8 __attribute__((ext_vector_type(8)));
typedef float f32x4 __attribute__((ext_vector_type(4)));
typedef unsigned u32x4 __attribute__((ext_vector_type(4)));
constexpr int BM = 256, BK = 64, HALF = 128, HTB = HALF * BK * 2  , STAGE_BYTES = 8 * HTB, NXCD = 8, WGM = 8;

__host__ __device__ __forceinline__ int lds_byte(int r, int c) { const int st = (r >> 4) * 2 + (c >> 5), rr = r & 15, cc = c & 31, ob = rr * 64 + cc * 2; return st * 1024 + (ob ^ (((ob >> 9) & 1) << 5)); }
__host__ __device__ __forceinline__ void stage_rc(int b, int& R, int& C) { const int st = b / 1024, sb = b % 1024, swz = sb ^ (((sb >> 9) & 1) << 5); R = (st >> 1) * 16 + swz / 64; C = (st & 1) * 32 + (swz % 64) / 2; }
__host__ __device__ __forceinline__ int perm32(int rho) { const int n = rho >> 4, i = rho & 15; return 8 * (i >> 2) + 4 * n + (i & 3); }

struct Unit { int pm, pn; };
struct Gemm { const bf16_t* A; const bf16_t* Bt; int M, N, K; };

struct StaticOrder {
    int nM, nN, nwg, G, c;
    __host__ __device__ void init(int M, int N, int G_, int c_) { nM = M / BM; nN = N / BM; nwg = nM * nN; G = G_; c = c_; }
    __host__ __device__ bool next(int i, Unit& u) const {
        const long L = (long)i * G + c; if (L >= nwg) return false;
        int wgid = (int)L; { const int q = nwg / NXCD, r = nwg % NXCD, xcd = wgid % NXCD, off = wgid / NXCD; wgid = (xcd < r ? xcd * (q + 1) : r * (q + 1) + (xcd - r) * q) + off; }
        const int nig = WGM * nN, gid = wgid / nig, fm = gid * WGM, gsz = (nM - fm) < WGM ? (nM - fm) : WGM;
        u.pm = fm + ((wgid % nig) % gsz); u.pn = (wgid % nig) / gsz; return true;
    }
    __device__ __forceinline__ void a_ready(const Unit&) const {}
    __device__ __forceinline__ void done(const Unit&) const {}
};

__device__ __forceinline__ unsigned cvt_pk_bf16(float lo, float hi) { unsigned r; asm volatile("v_cvt_pk_bf16_f32 %0, %1, %2" : "=v"(r) : "v"(lo), "v"(hi)); return r; }
typedef float f32x2 __attribute__((ext_vector_type(2)));
template <class Epi, class Sched, bool ALIGN_EPI = false, bool SP2 = false>
__device__ __forceinline__ void gemm_phase(PG8_LAS unsigned char* lds, const Gemm g, const Sched& S, const Epi& E) {
    int tid_ = threadIdx.x; asm volatile("" : "+v"(tid_));
    const int tid = tid_, wid = __builtin_amdgcn_readfirstlane(tid >> 6), lane = tid & 63, wr = wid >> 2, wc = wid & 3, fr = lane & 15, fq = lane >> 4;
    const int K = g.K, nt = K / BK;
    unsigned voffA[2], voffB[2];
#pragma unroll
    for (int i = 0; i < 2; ++i) { int R, C; stage_rc(tid * 16 + i * 8192, R, C); const int Rb = Epi::PERM ? ((R & ~31) + perm32(R & 31)) : R;
        voffA[i] = (unsigned)(R * K + C) * 2u; voffB[i] = (unsigned)(Rb * K + C) * 2u; }
    const size_t kstep = (size_t)(BK * 2);
    const size_t hstep = (size_t)HALF * K * 2;
    const size_t tstep = 2 * hstep;
    const unsigned ldsw = (unsigned)wid * 1024u;
    const int aoff = lds_byte(wr * 64 + fr, fq * 8), boff = lds_byte(wc * 32 + fr, fq * 8);
#define PG8_SA(b, h) (((b) * 2 + (h)) * HTB)
#define PG8_SB(b, h) ((4 + (b) * 2 + (h)) * HTB)
#define PG8_STAGE(bufoff, gbase, voff) do { _Pragma("unroll") for (int _i = 0; _i < 2; ++_i) \
        __builtin_amdgcn_global_load_lds((const unsigned*)((const char*)(gbase) + (voff)[_i]), (PG8_LAS unsigned*)(lds + (bufoff) + ldsw + _i * 8192), 16, 0, 0); } while (0)
#define PG8_LDA(dst, b, h) do { _Pragma("unroll") for (int m = 0; m < 4; ++m) _Pragma("unroll") for (int k = 0; k < 2; ++k) dst[m][k] = *(const PG8_LAS bf16x8*)(lds + PG8_SA(b, h) + aoff + m * 2048 + k * 1024); } while (0)
#define PG8_LDB(dst, b, h) do { _Pragma("unroll") for (int n = 0; n < 2; ++n) _Pragma("unroll") for (int k = 0; k < 2; ++k) dst[n][k] = *(const PG8_LAS bf16x8*)(lds + PG8_SB(b, h) + boff + n * 2048 + k * 1024); } while (0)
#define PG8_MMA(ai, bj, At, Bt) do { __builtin_amdgcn_s_setprio(1); _Pragma("unroll") for (int m = 0; m < 4; ++m) _Pragma("unroll") for (int n = 0; n < 2; ++n) _Pragma("unroll") for (int k = 0; k < 2; ++k) \
        acc[ai][bj][m][n] = __builtin_amdgcn_mfma_f32_16x16x32_bf16(Bt[n][k], At[m][k], acc[ai][bj][m][n], 0, 0, 0); __builtin_amdgcn_s_setprio(0); } while (0)
#define PG8_WAIT_V(n) asm volatile("s_waitcnt vmcnt(" #n ")" ::: "memory")
#define PG8_WAIT_L(n) asm volatile("s_waitcnt lgkmcnt(" #n ")" ::: "memory")
#define PG8_BAR __builtin_amdgcn_s_barrier()
#define PG8_SCHED __builtin_amdgcn_sched_barrier(0)
    Unit cur, nxt; int ui = 0;
    if (!S.next(0, cur)) return;
    f32x4 acc[2][2][4][2];
#pragma unroll
    for (int a = 0; a < 2; ++a)
#pragma unroll
        for (int b = 0; b < 2; ++b)
#pragma unroll
            for (int m = 0; m < 4; ++m)
#pragma unroll
                for (int n = 0; n < 2; ++n) acc[a][b][m][n] = (f32x4){0.f, 0.f, 0.f, 0.f};
    bf16x8 At[4][2], B0[2][2], B1[2][2];
    const char* cA = (const char*)g.A + (size_t)cur.pm * tstep; const char* cB = (const char*)g.Bt + (size_t)cur.pn * tstep;
    S.a_ready(cur);
    if constexpr (SP2) {
        PG8_STAGE(PG8_SB(0, 0), cB, voffB); PG8_STAGE(PG8_SB(0, 1), cB + hstep, voffB); PG8_STAGE(PG8_SA(0, 0), cA, voffA); PG8_STAGE(PG8_SA(0, 1), cA + hstep, voffA);
        if (wr == 1) PG8_BAR;
        PG8_WAIT_V(2); PG8_BAR;
        PG8_STAGE(PG8_SB(1, 0), cB + kstep, voffB); PG8_STAGE(PG8_SA(1, 0), cA + kstep, voffA); PG8_STAGE(PG8_SB(1, 1), cB + hstep + kstep, voffB);
        PG8_WAIT_V(6); PG8_BAR;
    } else {
        PG8_STAGE(PG8_SB(0, 0), cB, voffB); PG8_STAGE(PG8_SA(0, 0), cA, voffA); PG8_STAGE(PG8_SB(0, 1), cB + hstep, voffB); PG8_STAGE(PG8_SA(0, 1), cA + hstep, voffA);
        if (wr == 1) PG8_BAR;
        PG8_WAIT_V(4); PG8_BAR;
        PG8_STAGE(PG8_SB(1, 0), cB + kstep, voffB); PG8_STAGE(PG8_SA(1, 0), cA + kstep, voffA); PG8_STAGE(PG8_SB(1, 1), cB + hstep + kstep, voffB);
        PG8_WAIT_V(6); PG8_BAR;
    }
    for (;;) {
        const bool has_next = S.next(ui + 1, nxt);
        const char* nA = has_next ? (const char*)g.A + (size_t)nxt.pm * tstep : cA; const char* nB = has_next ? (const char*)g.Bt + (size_t)nxt.pn * tstep : cB;
        for (int t = 0; t < nt; t += 2) {
            const bool last = (t == nt - 2);
            const char* a1 = cA + (size_t)(t + 1) * kstep;
            const char* a2 = last ? nA : cA + (size_t)(t + 2) * kstep; const char* b2 = last ? nB : cB + (size_t)(t + 2) * kstep;
            const char* a3 = a2 + kstep; const char* b3 = b2 + kstep;
            if (last && has_next) S.a_ready(nxt);
            if constexpr (SP2) {
            PG8_LDB(B0, 0, 0); PG8_LDB(B1, 0, 1); PG8_SCHED; PG8_LDA(At, 0, 0); PG8_STAGE(PG8_SA(1, 1), a1 + hstep, voffA);
            PG8_WAIT_V(8); PG8_WAIT_L(0); PG8_BAR; PG8_MMA(0, 0, At, B0); PG8_MMA(0, 1, At, B1); PG8_BAR; PG8_SCHED;
            PG8_LDA(At, 0, 1); PG8_STAGE(PG8_SB(0, 0), b2, voffB); PG8_STAGE(PG8_SB(0, 1), b2 + hstep, voffB); PG8_STAGE(PG8_SA(0, 0), a2, voffA);
            PG8_WAIT_V(8); PG8_WAIT_L(0); PG8_BAR; PG8_MMA(1, 0, At, B0); PG8_MMA(1, 1, At, B1); PG8_BAR; PG8_SCHED;
            PG8_LDB(B0, 1, 0); PG8_LDB(B1, 1, 1); PG8_SCHED; PG8_LDA(At, 1, 0); PG8_STAGE(PG8_SA(0, 1), a2 + hstep, voffA);
            PG8_WAIT_V(8); PG8_WAIT_L(0); PG8_BAR; PG8_MMA(0, 0, At, B0); PG8_MMA(0, 1, At, B1); PG8_BAR; PG8_SCHED;
            PG8_LDA(At, 1, 1); PG8_STAGE(PG8_SB(1, 0), b3, voffB); PG8_STAGE(PG8_SB(1, 1), b3 + hstep, voffB); PG8_STAGE(PG8_SA(1, 0), a3, voffA);
            PG8_WAIT_V(8); PG8_WAIT_L(0); PG8_BAR; PG8_MMA(1, 0, At, B0); PG8_MMA(1, 1, At, B1); PG8_BAR; PG8_SCHED;
            } else {
            PG8_LDB(B0, 0, 0); PG8_SCHED; PG8_LDA(At, 0, 0); PG8_STAGE(PG8_SA(1, 1), a1 + hstep, voffA);
            PG8_WAIT_L(8); PG8_BAR; PG8_WAIT_L(0); PG8_MMA(0, 0, At, B0); PG8_BAR; PG8_SCHED;
            PG8_LDB(B1, 0, 1); PG8_STAGE(PG8_SB(0, 0), b2, voffB);
            PG8_BAR; PG8_WAIT_L(0); PG8_MMA(0, 1, At, B1); PG8_BAR;
            PG8_LDA(At, 0, 1); PG8_STAGE(PG8_SA(0, 0), a2, voffA);
            PG8_BAR; PG8_WAIT_L(0); PG8_MMA(1, 0, At, B0); PG8_BAR; PG8_SCHED;
            PG8_STAGE(PG8_SB(0, 1), b2 + hstep, voffB);
            PG8_WAIT_V(6); PG8_BAR; PG8_MMA(1, 1, At, B1); PG8_BAR;
            PG8_LDB(B0, 1, 0); PG8_SCHED; PG8_LDA(At, 1, 0); PG8_STAGE(PG8_SA(0, 1), a2 + hstep, voffA);
            PG8_WAIT_L(8); PG8_BAR; PG8_WAIT_L(0); PG8_MMA(0, 0, At, B0); PG8_BAR; PG8_SCHED;
            PG8_LDB(B1, 1, 1); PG8_STAGE(PG8_SB(1, 0), b3, voffB);
            PG8_BAR; PG8_WAIT_L(0); PG8_MMA(0, 1, At, B1); PG8_BAR;
            PG8_LDA(At, 1, 1); PG8_STAGE(PG8_SA(1, 0), a3, voffA);
            PG8_BAR; PG8_WAIT_L(0); PG8_MMA(1, 0, At, B0); PG8_BAR; PG8_SCHED;
            PG8_STAGE(PG8_SB(1, 1), b3 + hstep, voffB);
            PG8_WAIT_V(6); PG8_BAR; PG8_MMA(1, 1, At, B1); PG8_BAR;
            }
        }
        if constexpr (ALIGN_EPI) { if (wr == 0) PG8_BAR; }
        if constexpr (!Epi::AFTER_DRAIN) { E(acc, cur, wr, wc, fr, fq); S.done(cur); }
        if (!has_next) break;
#pragma unroll
        for (int a = 0; a < 2; ++a)
#pragma unroll
            for (int b = 0; b < 2; ++b)
#pragma unroll
                for (int m = 0; m < 4; ++m)
#pragma unroll
                    for (int n = 0; n < 2; ++n) acc[a][b][m][n] = (f32x4){0.f, 0.f, 0.f, 0.f};
        cur = nxt; cA = nA; cB = nB; ++ui;
        if constexpr (ALIGN_EPI) { if (wr == 1) PG8_BAR; }
    }
    PG8_WAIT_V(0);
    if constexpr (!ALIGN_EPI) { if (wr == 0) PG8_BAR; }
    PG8_BAR;
    if constexpr (Epi::AFTER_DRAIN) { E.fused(acc, cur, wr, wc, fr, fq, lds, wid, lane); S.done(cur); }
#undef PG8_SA
#undef PG8_SB
#undef PG8_STAGE
#undef PG8_LDA
#undef PG8_LDB
#undef PG8_MMA
#undef PG8_WAIT_V
#undef PG8_WAIT_L
#undef PG8_BAR
#undef PG8_SCHED
}
}

#define LAS __attribute__((address_space(3)))
typedef unsigned short bf16;
typedef short bf16x8 __attribute__((ext_vector_type(8)));
typedef short s16x4 __attribute__((ext_vector_type(4)));
typedef float f32x4 __attribute__((ext_vector_type(4)));
typedef float f32x16 __attribute__((ext_vector_type(16)));
typedef unsigned u32x4 __attribute__((ext_vector_type(4)));
typedef unsigned u32x2 __attribute__((ext_vector_type(2)));
typedef float f32x2_t __attribute__((ext_vector_type(2)));
typedef __bf16 bf16x2_t __attribute__((ext_vector_type(2)));

constexpr int NB = 4, SEQ = 4096, DM = 1024, MTOK = NB * SEQ, DFF = 2816, NPROJ = 2816, INCOLS = 2820;
constexpr float ALPHA = 1.41421356237309515f, LN_EPS = 1e-5f, LOG2E = 1.4426950408889634f;
constexpr size_t MiB = 1u << 20;
constexpr size_t WS_CTL = 0, WS_ROPE = 1 * MiB, WS_W1T = 2 * MiB, WS_W2T = 46 * MiB, WS_WINT = 68 * MiB, WS_WOT = 79 * MiB, WS_HB = 83 * MiB, WS_LGF = 115 * MiB,
                 WS_ACT = 116 * MiB, WS_AV = 116 * MiB, WS_AG = 124 * MiB, WS_BQ = 132 * MiB, WS_BK = 140 * MiB, WS_BVT = 148 * MiB, WS_CQ = 156 * MiB, WS_CK = 172 * MiB,
                 WS_CVT1 = 188 * MiB, WS_CVT4 = 204 * MiB, WS_CVT16 = 220 * MiB, WS_YCAT = 236 * MiB, WS_END = 268 * MiB;
constexpr int LDS_BYTES = 147456, LDS_MISC = 131072;
constexpr int NTHR = 512;
constexpr int CW_BAR = 4096;
#define XCD_BAR_WORDS 3456

__device__ __forceinline__ unsigned cvtpk(float lo, float hi) { f32x2_t v = {lo, hi}; bf16x2_t b = __builtin_convertvector(v, bf16x2_t); return __builtin_bit_cast(unsigned, b); }
__device__ __forceinline__ unsigned short f2bf(float f) { return (unsigned short)(cvtpk(f, 0.f) & 0xffffu); }
__device__ __forceinline__ float bf2f(unsigned short b) { return __builtin_bit_cast(float, (unsigned)b << 16); }
__device__ __forceinline__ float wave_sum(float v) {
#pragma unroll
    for (int o = 1; o < 64; o <<= 1) v += __shfl_xor(v, o);
    return v;
}
__device__ __forceinline__ float silu_f(float g) { return g * __builtin_amdgcn_rcpf(1.f + __expf(-g)); }
__device__ __forceinline__ float sigmoid_f(float g) { return __builtin_amdgcn_rcpf(1.f + __expf(-g)); }

struct EpiSwiGLU {
    static constexpr bool PERM = true, AFTER_DRAIN = false;
    bf16* O;
    __device__ __forceinline__ void operator()(const pg8::f32x4 (&acc)[2][2][4][2], const pg8::Unit& u, int wr, int wc, int fr, int fq) const {
        const int row0 = u.pm * 256 + wr * 64 + fr, col0 = u.pn * 128 + wc * 32 + 8 * fq;
#pragma unroll
        for (int ai = 0; ai < 2; ++ai)
#pragma unroll
            for (int m = 0; m < 4; ++m) {
                const pg8::f32x4 g0 = acc[ai][0][m][0], g1 = acc[ai][0][m][1], u0 = acc[ai][1][m][0], u1 = acc[ai][1][m][1];
                u32x4 w;
                w.x = pg8::cvt_pk_bf16(silu_f(g0[0]) * u0[0], silu_f(g0[1]) * u0[1]); w.y = pg8::cvt_pk_bf16(silu_f(g0[2]) * u0[2], silu_f(g0[3]) * u0[3]);
                w.z = pg8::cvt_pk_bf16(silu_f(g1[0]) * u1[0], silu_f(g1[1]) * u1[1]); w.w = pg8::cvt_pk_bf16(silu_f(g1[2]) * u1[2], silu_f(g1[3]) * u1[3]);
                *(u32x4*)(O + (size_t)(row0 + ai * 128 + m * 16) * DFF + col0) = w;
            }
    }
};
struct EpiResid {
    static constexpr bool PERM = true, AFTER_DRAIN = false;
    const float* res; float* out; float scale;
    __device__ __forceinline__ void operator()(const pg8::f32x4 (&acc)[2][2][4][2], const pg8::Unit& u, int wr, int wc, int fr, int fq) const {
        const int row0 = u.pm * 256 + wr * 64 + fr, col0 = u.pn * 256 + wc * 32 + 8 * fq;
#pragma unroll
        for (int ai = 0; ai < 2; ++ai)
#pragma unroll
            for (int m = 0; m < 4; ++m)
#pragma unroll
                for (int bj = 0; bj < 2; ++bj) {
                    const size_t off = (size_t)(row0 + ai * 128 + m * 16) * DM + col0 + bj * 128;
                    const f32x4 r0 = *(const f32x4*)(res + off), r1 = *(const f32x4*)(res + off + 4);
                    f32x4 o0, o1;
#pragma unroll
                    for (int e = 0; e < 4; ++e) { o0[e] = ALPHA * r0[e] + scale * acc[ai][bj][m][0][e]; o1[e] = ALPHA * r1[e] + scale * acc[ai][bj][m][1][e]; }
                    *(f32x4*)(out + off) = o0; *(f32x4*)(out + off + 4) = o1;
                }
    }
};
struct EpiProj {
    static constexpr bool PERM = true, AFTER_DRAIN = false;
    bf16 *AV, *AG, *BQ, *BK, *BVT, *CQ, *CK, *CVT1, *CVT4, *CVT16; const float* rope;
    __device__ __forceinline__ void operator()(const pg8::f32x4 (&acc)[2][2][4][2], const pg8::Unit& u, int wr, int wc, int fr, int fq) const {
        const int pn = u.pn;
        const int rbase = u.pm * 256 + wr * 64;
        if (pn <= 3) {
#pragma unroll
            for (int ai = 0; ai < 2; ++ai)
#pragma unroll
                for (int m = 0; m < 4; ++m)
#pragma unroll
                    for (int bj = 0; bj < 2; ++bj) {
                        const int row = rbase + ai * 128 + m * 16 + fr, cl = bj * 128 + wc * 32 + 8 * fq;
                        const pg8::f32x4 v0 = acc[ai][bj][m][0], v1 = acc[ai][bj][m][1];
                        u32x4 w; w.x = pg8::cvt_pk_bf16(v0[0], v0[1]); w.y = pg8::cvt_pk_bf16(v0[2], v0[3]); w.z = pg8::cvt_pk_bf16(v1[0], v1[1]); w.w = pg8::cvt_pk_bf16(v1[2], v1[3]);
                        if (pn <= 1) { bf16* dst = (pn == 0 ? AV : AG) + (size_t)row * 256 + cl; *(u32x4*)dst = w; }
                        else { const int b = row >> 12, s = row & 4095, head = cl >> 6, dd = cl & 63;
                               bf16* dst = (pn == 2 ? BQ : BK) + ((size_t)((b * 4 + head) * 4096 + s)) * 64 + dd; *(u32x4*)dst = w; }
                    }
        } else if (pn == 4) {
#pragma unroll
            for (int ai = 0; ai < 2; ++ai)
#pragma unroll
                for (int m = 0; m < 4; ++m)
#pragma unroll
                    for (int bj = 0; bj < 2; ++bj) {
                        const int row = rbase + ai * 128 + m * 16 + fr, cl = bj * 128 + wc * 32 + 8 * fq;
                        const int b = row >> 12, s = row & 4095, head = cl >> 6, dd = cl & 63;
                        bf16* dst = BVT + ((size_t)((b * 4 + head) * 64 + dd)) * 4096 + s;
#pragma unroll
                        for (int n = 0; n < 2; ++n)
#pragma unroll
                            for (int e = 0; e < 4; ++e) dst[(size_t)(4 * n + e) * 4096] = f2bf(acc[ai][bj][m][n][e]);
                    }
        } else if (pn <= 8) {
            const bool isq = pn <= 6; const float sc = isq ? 0.125f : 1.0f; const int hb = ((pn - 5) & 1) * 4;
            bf16* base = isq ? CQ : CK;
#pragma unroll
            for (int ai = 0; ai < 2; ++ai)
#pragma unroll
                for (int m = 0; m < 4; ++m)
#pragma unroll
                    for (int bj = 0; bj < 2; ++bj) {
                        const int row = rbase + ai * 128 + m * 16 + fr, cl = bj * 128 + wc * 32 + 8 * fq;
                        const int b = row >> 12, s = row & 4095, head = hb + (cl >> 6), dd = cl & 63, i0 = dd >> 1;
                        const f32x4 c4 = *(const f32x4*)(rope + (size_t)s * 32 + i0), s4 = *(const f32x4*)(rope + 4096 * 32 + (size_t)s * 32 + i0);
                        const pg8::f32x4 v0 = acc[ai][bj][m][0], v1 = acc[ai][bj][m][1];
                        u32x4 w;
                        w.x = pg8::cvt_pk_bf16((v0[0] * c4[0] - v0[1] * s4[0]) * sc, (v0[1] * c4[0] + v0[0] * s4[0]) * sc);
                        w.y = pg8::cvt_pk_bf16((v0[2] * c4[1] - v0[3] * s4[1]) * sc, (v0[3] * c4[1] + v0[2] * s4[1]) * sc);
                        w.z = pg8::cvt_pk_bf16((v1[0] * c4[2] - v1[1] * s4[2]) * sc, (v1[1] * c4[2] + v1[0] * s4[2]) * sc);
                        w.w = pg8::cvt_pk_bf16((v1[2] * c4[3] - v1[3] * s4[3]) * sc, (v1[3] * c4[3] + v1[2] * s4[3]) * sc);
                        *(u32x4*)(base + ((size_t)((b * 8 + head) * 4096 + s)) * 64 + dd) = w;
                    }
        } else {
            const int hb = (pn - 9) * 4;
#pragma unroll
            for (int ai = 0; ai < 2; ++ai)
#pragma unroll
                for (int bj = 0; bj < 2; ++bj) {
                    const int cl = bj * 128 + wc * 32 + 8 * fq, head = hb + (cl >> 6), dd = cl & 63;
                    const int row_b = rbase + ai * 128, b = row_b >> 12, sb = row_b & 4095;
                    bf16* p1 = CVT1 + ((size_t)((b * 8 + head) * 64 + dd)) * 4096;
                    bf16* p4 = CVT4 + ((size_t)((b * 8 + head) * 64 + dd)) * 4096;
                    bf16* p16 = CVT16 + ((size_t)((b * 8 + head) * 64 + dd)) * 4096;
#pragma unroll
                    for (int n = 0; n < 2; ++n)
#pragma unroll
                        for (int e = 0; e < 4; ++e) {
                            const size_t co = (size_t)(4 * n + e) * 4096;
                            const float x0 = acc[ai][bj][0][n][e], x1 = acc[ai][bj][1][n][e], x2 = acc[ai][bj][2][n][e], x3 = acc[ai][bj][3][n][e];
                            u32x2 w16; w16.x = pg8::cvt_pk_bf16(x0, x1); w16.y = pg8::cvt_pk_bf16(x2, x3);
                            *(u32x2*)(p16 + co + fr * 256 + (sb >> 4)) = w16;
                            const unsigned short h0 = (unsigned short)(w16.x & 0xffffu), h1 = (unsigned short)(w16.x >> 16), h2 = (unsigned short)(w16.y & 0xffffu), h3 = (unsigned short)(w16.y >> 16);
                            p1[co + sb + fr] = h0; p1[co + sb + 16 + fr] = h1; p1[co + sb + 32 + fr] = h2; p1[co + sb + 48 + fr] = h3;
                            bf16* q4 = p4 + co + (fr & 3) * 1024 + ((sb + fr) >> 2);
                            q4[0] = h0; q4[4] = h1; q4[8] = h2; q4[12] = h3;
                        }
                }
        }
    }
};

struct Args {
    const float *x, *w_in, *w_o, *fbias, *conv_w, *conv_b, *conv_g, *conv_beta, *ffn_w_in, *ffn_w_out, *ln_g, *ln_b;
    float* out; unsigned char* ws;
};

__device__ __forceinline__ int src_col(int mode, int n) {
    if (mode == 1) return ((n & 255) >> 7) * DFF + (n >> 8) * 128 + (n & 127);
    if (mode == 2) { if (n < 1280) return n; const int np = n - 1280; if (np < 1024) { const int p = np & 63; return 1284 + (np & ~63) + (p >> 1) + 32 * (p & 1); } return 1284 + np; }
    return n;
}
__device__ __forceinline__ void transpose_item(const float* __restrict__ W, int K, int Nsrc, bf16* __restrict__ Wt, int mode, int kb, int nb, LAS float* t, int tid) {
    const int k0 = kb * 64, n0 = nb * 64, nl = tid & 63, sc = src_col(mode, n0 + nl);
#pragma unroll
    for (int i = 0; i < 8; ++i) { const int kk = (tid >> 6) + 8 * i; t[kk * 65 + nl] = W[(size_t)(k0 + kk) * Nsrc + sc]; }
    __syncthreads();
    const int n2 = tid >> 3, kc = (tid & 7) * 8;
    u32x4 w;
    w.x = cvtpk(t[(kc + 0) * 65 + n2], t[(kc + 1) * 65 + n2]); w.y = cvtpk(t[(kc + 2) * 65 + n2], t[(kc + 3) * 65 + n2]);
    w.z = cvtpk(t[(kc + 4) * 65 + n2], t[(kc + 5) * 65 + n2]); w.w = cvtpk(t[(kc + 6) * 65 + n2], t[(kc + 7) * 65 + n2]);
    *(u32x4*)(Wt + (size_t)(n0 + n2) * K + k0 + kc) = w;
    __syncthreads();
}
__device__ __forceinline__ void prologue(const Args& a, LAS unsigned char* lds) {
    const int tid = threadIdx.x, G = gridDim.x, bx = blockIdx.x;
    unsigned char* ws = a.ws;
    if (bx == 0) { if (tid < 64) ((unsigned*)(ws + WS_CTL))[tid] = 0u;
        for (int i = tid; i < XCD_BAR_WORDS; i += NTHR) ((unsigned*)(ws + WS_CTL))[CW_BAR + i] = 0u; }
    { float* rc = (float*)(ws + WS_ROPE); float* rs = rc + 4096 * 32;
      for (int i = bx * NTHR + tid; i < 4096 * 32; i += G * NTHR) { const int pos = i >> 5, j = i & 31;
          const float inv = (float)(1.0 / pow(10000.0, (double)(2 * j) / 64.0)); const float ang = (float)pos * inv;
          rc[i] = (float)cos((double)ang); rs[i] = (float)sin((double)ang); } }
    { bf16* hb = (bf16*)(ws + WS_HB);
      for (size_t i = (size_t)bx * NTHR + tid; i < (size_t)MTOK * DM / 8; i += (size_t)G * NTHR) {
          const f32x4 v0 = *(const f32x4*)(a.x + i * 8), v1 = *(const f32x4*)(a.x + i * 8 + 4);
          u32x4 w; w.x = cvtpk(v0[0], v0[1]); w.y = cvtpk(v0[2], v0[3]); w.z = cvtpk(v1[0], v1[1]); w.w = cvtpk(v1[2], v1[3]);
          *(u32x4*)(hb + i * 8) = w; } }
    LAS float* t = (LAS float*)lds;
    constexpr int I1 = 16 * 88, I2 = 44 * 16, I3 = 16 * 44, I4 = 16 * 16, NIT = 4 * I1 + 4 * I2 + 2 * I3 + 2 * I4;
    for (int it = bx; it < NIT; it += G) {
        int r = it;
        if (r < 4 * I1) { const int mi = r / I1, q = r % I1; transpose_item(a.ffn_w_in + (size_t)mi * 1024 * 5632, 1024, 5632, (bf16*)(ws + WS_W1T) + (size_t)mi * 5632 * 1024, 1, q / 88, q % 88, t, tid); continue; }
        r -= 4 * I1;
        if (r < 4 * I2) { const int mi = r / I2, q = r % I2; transpose_item(a.ffn_w_out + (size_t)mi * DFF * 1024, DFF, 1024, (bf16*)(ws + WS_W2T) + (size_t)mi * 1024 * DFF, 0, q / 16, q % 16, t, tid); continue; }
        r -= 4 * I2;
        if (r < 2 * I3) { const int mi = r / I3, q = r % I3; transpose_item(a.w_in + (size_t)mi * 1024 * INCOLS, 1024, INCOLS, (bf16*)(ws + WS_WINT) + (size_t)mi * NPROJ * 1024, 2, q / 44, q % 44, t, tid); continue; }
        r -= 2 * I3;
        { const int mi = r / I4, q = r % I4; transpose_item(a.w_o + (size_t)mi * 1024 * 1024, 1024, 1024, (bf16*)(ws + WS_WOT) + (size_t)mi * 1024 * 1024, 0, q / 16, q % 16, t, tid); }
    }
}

__device__ __forceinline__ void ln_phase(float* Y, bf16* HB, const float* __restrict__ g, const float* __restrict__ bt, bool fgate, const float* __restrict__ w_in_l,
                                         const float* __restrict__ fbias, float* lgf, LAS unsigned char* lds) {
    int tid_ = threadIdx.x; asm volatile("" : "+v"(tid_));
    const int tid = tid_, lane = tid & 63, wid = tid >> 6, G = gridDim.x;
    LAS f32x4* wf = (LAS f32x4*)lds;
    if (fgate) { for (int k = tid; k < 1024; k += NTHR) wf[k] = *(const f32x4*)(w_in_l + (size_t)k * INCOLS + 1280); }
    __syncthreads();
    f32x4 gv[4], bv[4];
#pragma unroll
    for (int j = 0; j < 4; ++j) { gv[j] = *(const f32x4*)(g + 256 * j + 4 * lane); bv[j] = *(const f32x4*)(bt + 256 * j + 4 * lane); }
    for (int row = blockIdx.x * 8 + wid; row < MTOK; row += G * 8) {
        float* yr = Y + (size_t)row * DM;
        f32x4 v[4]; float s = 0.f;
#pragma unroll
        for (int j = 0; j < 4; ++j) { v[j] = *(const f32x4*)(yr + 256 * j + 4 * lane); s += (v[j][0] + v[j][1]) + (v[j][2] + v[j][3]); }
        const float mean = wave_sum(s) * (1.f / DM); float s2 = 0.f;
#pragma unroll
        for (int j = 0; j < 4; ++j) { v[j] = v[j] - mean; s2 += (v[j][0] * v[j][0] + v[j][1] * v[j][1]) + (v[j][2] * v[j][2] + v[j][3] * v[j][3]); }
        const float rstd = 1.0f / sqrtf(wave_sum(s2) * (1.f / DM) + LN_EPS);
        f32x4 z = {0.f, 0.f, 0.f, 0.f};
#pragma unroll
        for (int j = 0; j < 4; ++j) {
            f32x4 o;
#pragma unroll
            for (int e = 0; e < 4; ++e) o[e] = v[j][e] * rstd * gv[j][e] + bv[j][e];
            *(f32x4*)(yr + 256 * j + 4 * lane) = o;
            u32x2 w; w.x = cvtpk(o[0], o[1]); w.y = cvtpk(o[2], o[3]);
            *(u32x2*)(HB + (size_t)row * DM + 256 * j + 4 * lane) = w;
            if (fgate) {
#pragma unroll
                for (int e = 0; e < 4; ++e) { const f32x4 wv = wf[256 * j + 4 * lane + e]; z = z + wv * o[e]; }
            }
        }
        if (fgate) {
            z[0] = wave_sum(z[0]); z[1] = wave_sum(z[1]); z[2] = wave_sum(z[2]); z[3] = wave_sum(z[3]);
            if (lane < 4) { const float zz = (lane == 0 ? z[0] : lane == 1 ? z[1] : lane == 2 ? z[2] : z[3]) + fbias[lane];
                const float ls = fminf(zz, 0.f) - log1pf(expf(-fabsf(zz)));
                lgf[(size_t)(((row >> 12) * 4 + lane)) * 4096 + (row & 4095)] = ls; }
        }
    }
    __syncthreads();
}

#define MFMA32(a, b, c) __builtin_amdgcn_mfma_f32_32x32x16_bf16((a), (b), (c), 0, 0, 0)
__device__ __forceinline__ bf16x8 pack8(const f32x16& x, int s) {
    u32x4 p; p.x = cvtpk(x[8 * s + 0], x[8 * s + 1]); p.y = cvtpk(x[8 * s + 2], x[8 * s + 3]); p.z = cvtpk(x[8 * s + 4], x[8 * s + 5]); p.w = cvtpk(x[8 * s + 6], x[8 * s + 7]);
    return __builtin_bit_cast(bf16x8, p);
}
constexpr int FK_OFF = 0, FV_OFF = 18432, FCUM_OFF = 36864, FSCR_OFF = 53248, KV_PITCH = 144;

__device__ __forceinline__ void fox_unit(LAS unsigned char* lds, int b, int head, int qb, const bf16* __restrict__ BQ, const bf16* __restrict__ BK, const bf16* __restrict__ BVT,
                                         const float* __restrict__ lgf, bf16* YCAT) {
    int tid_ = threadIdx.x; asm volatile("" : "+v"(tid_));
    const int tid = tid_, lane = tid & 63, wid = tid >> 6, r = lane & 31, h = lane >> 5;
    const int q0 = qb * 256, kend = q0 + 256, ntiles = kend / 64, bh = b * 4 + head;
    LAS float* cum = (LAS float*)(lds + FCUM_OFF); LAS float* scr = (LAS float*)(lds + FSCR_OFF);
    {
        const float* lf = lgf + (size_t)bh * 4096;
        float v[8];
        if (8 * tid < kend) { const f32x4 a0 = *(const f32x4*)(lf + 8 * tid), a1 = *(const f32x4*)(lf + 8 * tid + 4); v[0] = a0[0]; v[1] = a0[1]; v[2] = a0[2]; v[3] = a0[3]; v[4] = a1[0]; v[5] = a1[1]; v[6] = a1[2]; v[7] = a1[3]; }
        else {
#pragma unroll
            for (int j = 0; j < 8; ++j) v[j] = 0.f; }
#pragma unroll
        for (int j = 1; j < 8; ++j) v[j] += v[j - 1];
        const float total = v[7]; float t = total;
#pragma unroll
        for (int o = 1; o < 64; o <<= 1) { const float n = __shfl_up(t, o); if (lane >= o) t += n; }
        if (lane == 63) scr[wid] = t;
        __syncthreads();
        float woff = 0.f;
        for (int w = 0; w < wid; ++w) woff += scr[w];
        const float base = woff + t - total;
#pragma unroll
        for (int j = 0; j < 8; ++j) cum[8 * tid + j] = (base + v[j]) * LOG2E;
    }
    __syncthreads();
    const int qrow = q0 + 32 * wid + r;
    bf16x8 qf[4];
    { const bf16* qp = BQ + ((size_t)bh * 4096 + qrow) * 64 + 8 * h;
#pragma unroll
      for (int ks = 0; ks < 4; ++ks) qf[ks] = *(const bf16x8*)(qp + 16 * ks); }
    const float cq2 = cum[qrow];
    const int my_last = (q0 + 32 * wid + 31) >> 6;
    const float C1 = 0.125f * LOG2E;
    f32x16 o0, o1;
#pragma unroll
    for (int i = 0; i < 16; ++i) { o0[i] = 0.f; o1[i] = 0.f; }
    float m_run = -INFINITY, l_run = 0.f;
    const int srow = tid >> 3, sch = tid & 7;
    const bf16* kg = BK + ((size_t)bh * 4096 + srow) * 64 + sch * 8;
    const bf16* vg = BVT + ((size_t)bh * 64 + srow) * 4096 + sch * 8;
    const int soff = srow * KV_PITCH + sch * 16;
    u32x4 kreg = *(const u32x4*)kg, vreg = *(const u32x4*)vg;
    *(LAS u32x4*)(lds + FK_OFF + soff) = kreg; *(LAS u32x4*)(lds + FV_OFF + soff) = vreg;
    __syncthreads();
    for (int kt = 0; kt < ntiles; ++kt) {
        const int buf = kt & 1;
        if (kt + 1 < ntiles) { kreg = *(const u32x4*)(kg + (size_t)(kt + 1) * 4096); vreg = *(const u32x4*)(vg + (kt + 1) * 64); }
        if (kt <= my_last) {
            LAS unsigned char* Kb = lds + FK_OFF + buf * 9216; LAS unsigned char* Vb = lds + FV_OFF + buf * 9216;
            f32x16 st0, st1;
#pragma unroll
            for (int i = 0; i < 16; ++i) { st0[i] = 0.f; st1[i] = 0.f; }
#pragma unroll
            for (int ks = 0; ks < 4; ++ks) {
                const bf16x8 a0 = *(const LAS bf16x8*)(Kb + r * KV_PITCH + (16 * ks + 8 * h) * 2);
                const bf16x8 a1 = *(const LAS bf16x8*)(Kb + (32 + r) * KV_PITCH + (16 * ks + 8 * h) * 2);
                st0 = MFMA32(a0, qf[ks], st0); st1 = MFMA32(a1, qf[ks], st1);
            }
            const int kbase = kt * 64;
            const bool diag = (kbase + 63) > (q0 + 32 * wid);
            float mx = -INFINITY;
#pragma unroll
            for (int gq = 0; gq < 4; ++gq) {
                const f32x4 c0 = *(const LAS f32x4*)(cum + kbase + 8 * gq + 4 * h), c1 = *(const LAS f32x4*)(cum + kbase + 32 + 8 * gq + 4 * h);
#pragma unroll
                for (int e = 0; e < 4; ++e) {
                    const int i = 4 * gq + e, key0 = kbase + 8 * gq + 4 * h + e;
                    float x0 = st0[i] * C1 + (cq2 - c0[e]), x1 = st1[i] * C1 + (cq2 - c1[e]);
                    if (diag) { if (key0 > qrow) x0 = -INFINITY; if (key0 + 32 > qrow) x1 = -INFINITY; }
                    st0[i] = x0; st1[i] = x1; mx = fmaxf(mx, fmaxf(x0, x1));
                }
            }
            mx = fmaxf(mx, __shfl_xor(mx, 32));
            const float m_new = fmaxf(m_run, mx);
            const float al = exp2f(m_run - m_new);
            float ps = 0.f;
#pragma unroll
            for (int i = 0; i < 16; ++i) { st0[i] = exp2f(st0[i] - m_new); st1[i] = exp2f(st1[i] - m_new); ps += st0[i] + st1[i]; o0[i] *= al; o1[i] *= al; }
            l_run = l_run * al + ps; m_run = m_new;
#pragma unroll
            for (int s2 = 0; s2 < 2; ++s2) {
                const bf16x8 p0 = pack8(st0, s2), p1 = pack8(st1, s2);
#pragma unroll
                for (int ds = 0; ds < 2; ++ds) {
                    const LAS unsigned char* vr = Vb + (32 * ds + r) * KV_PITCH;
                    const s16x4 lo0 = *(const LAS s16x4*)(vr + (16 * s2 + 4 * h) * 2), hi0 = *(const LAS s16x4*)(vr + (16 * s2 + 8 + 4 * h) * 2);
                    const s16x4 lo1 = *(const LAS s16x4*)(vr + (32 + 16 * s2 + 4 * h) * 2), hi1 = *(const LAS s16x4*)(vr + (32 + 16 * s2 + 8 + 4 * h) * 2);
                    const bf16x8 va0 = __builtin_shufflevector(lo0, hi0, 0, 1, 2, 3, 4, 5, 6, 7), va1 = __builtin_shufflevector(lo1, hi1, 0, 1, 2, 3, 4, 5, 6, 7);
                    if (ds == 0) { o0 = MFMA32(va0, p0, o0); o0 = MFMA32(va1, p1, o0); } else { o1 = MFMA32(va0, p0, o1); o1 = MFMA32(va1, p1, o1); }
                }
            }
        }
        if (kt + 1 < ntiles) { *(LAS u32x4*)(lds + FK_OFF + (buf ^ 1) * 9216 + soff) = kreg; *(LAS u32x4*)(lds + FV_OFF + (buf ^ 1) * 9216 + soff) = vreg; }
        __syncthreads();
    }
    const float lt = l_run + __shfl_xor(l_run, 32), inv = 1.0f / lt;
    bf16* yo = YCAT + ((size_t)(b * 4096 + qrow)) * DM + 256 + head * 64 + 4 * h;
#pragma unroll
    for (int gq = 0; gq < 4; ++gq) {
        u32x2 w0, w1;
        w0.x = cvtpk(o0[4 * gq] * inv, o0[4 * gq + 1] * inv); w0.y = cvtpk(o0[4 * gq + 2] * inv, o0[4 * gq + 3] * inv);
        w1.x = cvtpk(o1[4 * gq] * inv, o1[4 * gq + 1] * inv); w1.y = cvtpk(o1[4 * gq + 2] * inv, o1[4 * gq + 3] * inv);
        *(u32x2*)(yo + 8 * gq) = w0; *(u32x2*)(yo + 32 + 8 * gq) = w1;
    }
}

__device__ __forceinline__ void dil_unit(int b, int head, int blk, const bf16* __restrict__ CQ, const bf16* __restrict__ CK, const bf16* __restrict__ CVT1, const bf16* __restrict__ CVT4,
                                         const bf16* __restrict__ CVT16, bf16* YCAT) {
    int tid_ = threadIdx.x; asm volatile("" : "+v"(tid_));
    const int tid = tid_, lane = tid & 63, wid = tid >> 6, r = lane & 31, h = lane >> 5;
    const int t0 = blk * 512, bh = b * 8 + head;
    for (int gi = 0; gi < 2; ++gi) {
        const int rr = 2 * wid + gi, pq = t0 + rr + 16 * r;
        bf16x8 qf[4];
        { const bf16* qp = CQ + ((size_t)bh * 4096 + pq) * 64 + 8 * h;
#pragma unroll
          for (int ks = 0; ks < 4; ++ks) qf[ks] = *(const bf16x8*)(qp + 16 * ks); }
        f32x16 o0, o1;
#pragma unroll
        for (int i = 0; i < 16; ++i) { o0[i] = 0.f; o1[i] = 0.f; }
        float m_run = -INFINITY, l_run = 0.f;
        for (int br = 0; br < 3; ++br) {
            const int lgd = 2 * br, d = 1 << lgd, res = rr & (d - 1), nsubidx = 4096 >> lgd;
            const bf16* VT = (br == 0 ? CVT1 : br == 1 ? CVT4 : CVT16) + (size_t)bh * 64 * 4096 + (size_t)res * nsubidx;
            const int mq0 = (t0 + rr) >> lgd, ms0 = (mq0 - 128) & ~3, last = mq0 + (496 >> lgd), nsub = ((last - ms0) >> 5) + 1;
            const int mq = pq >> lgd;
            for (int sub = 0; sub < nsub; ++sub) {
                const int msk = ms0 + 32 * sub;
                if (msk + 31 < 0) continue;
                int pos = (msk + r) * d + res; pos = pos < 0 ? 0 : (pos > 4095 ? 4095 : pos);
                const bf16* kp = CK + ((size_t)bh * 4096 + pos) * 64 + 8 * h;
                bf16x8 ka[4];
#pragma unroll
                for (int ks = 0; ks < 4; ++ks) ka[ks] = *(const bf16x8*)(kp + 16 * ks);
                bf16x8 va[2][2];
#pragma unroll
                for (int s2 = 0; s2 < 2; ++s2) {
                    int c0 = msk + 16 * s2 + 4 * h, c1 = c0 + 8;
                    c0 = (c0 < 0 || c0 >= nsubidx) ? 0 : c0; c1 = (c1 < 0 || c1 >= nsubidx) ? 0 : c1;
#pragma unroll
                    for (int ds = 0; ds < 2; ++ds) {
                        const bf16* vp = VT + (size_t)(32 * ds + r) * 4096;
                        const s16x4 lo = *(const s16x4*)(vp + c0), hi = *(const s16x4*)(vp + c1);
                        va[s2][ds] = __builtin_shufflevector(lo, hi, 0, 1, 2, 3, 4, 5, 6, 7);
                    }
                }
                f32x16 st;
#pragma unroll
                for (int i = 0; i < 16; ++i) st[i] = 0.f;
#pragma unroll
                for (int ks = 0; ks < 4; ++ks) st = MFMA32(ka[ks], qf[ks], st);
                float mx = -INFINITY;
#pragma unroll
                for (int i = 0; i < 16; ++i) {
                    const int mk = msk + (i & 3) + 8 * (i >> 2) + 4 * h, dist = mq - mk;
                    const bool valid = (mk >= 0) && (dist >= 0) && (dist <= 128);
                    const float x = valid ? st[i] * LOG2E : -INFINITY;
                    st[i] = x; mx = fmaxf(mx, x);
                }
                mx = fmaxf(mx, __shfl_xor(mx, 32));
                const float m_new = fmaxf(m_run, mx);
                const float m_use = (m_new == -INFINITY) ? 0.f : m_new;
                const float al = exp2f(m_run - m_use);
                float ps = 0.f;
#pragma unroll
                for (int i = 0; i < 16; ++i) { st[i] = exp2f(st[i] - m_use); ps += st[i]; o0[i] *= al; o1[i] *= al; }
                l_run = l_run * al + ps; m_run = m_new;
#pragma unroll
                for (int s2 = 0; s2 < 2; ++s2) {
                    const bf16x8 p = pack8(st, s2);
                    o0 = MFMA32(va[s2][0], p, o0); o1 = MFMA32(va[s2][1], p, o1);
                }
            }
        }
        const float lt = l_run + __shfl_xor(l_run, 32), inv = 1.0f / lt;
        bf16* yo = YCAT + ((size_t)(b * 4096 + pq)) * DM + 512 + head * 64 + 4 * h;
#pragma unroll
        for (int gq = 0; gq < 4; ++gq) {
            u32x2 w0, w1;
            w0.x = cvtpk(o0[4 * gq] * inv, o0[4 * gq + 1] * inv); w0.y = cvtpk(o0[4 * gq + 2] * inv, o0[4 * gq + 3] * inv);
            w1.x = cvtpk(o1[4 * gq] * inv, o1[4 * gq + 1] * inv); w1.y = cvtpk(o1[4 * gq + 2] * inv, o1[4 * gq + 3] * inv);
            *(u32x2*)(yo + 8 * gq) = w0; *(u32x2*)(yo + 32 + 8 * gq) = w1;
        }
    }
}

__device__ __forceinline__ void conv_unit(LAS unsigned char* lds, int b, int tile, const bf16* __restrict__ AV, const bf16* __restrict__ AG, const float* __restrict__ cw,
                                          const float* __restrict__ cb, const float* __restrict__ cg_, const float* __restrict__ cbeta, bf16* YCAT) {
    int tid_ = threadIdx.x; asm volatile("" : "+v"(tid_));
    const int tid = tid_, lane = tid & 63, wid = tid >> 6;
    const int t0 = tile * 32;
    LAS float* u = (LAS float*)lds;
    LAS float* co = (LAS float*)(lds + 63488);
    for (int c = tid; c < 62 * 32; c += NTHR) {
        const int tt = c >> 5, ch = (c & 31) * 8, t = t0 - 30 + tt;
        float uv[8];
        if (t >= 0) {
            const size_t off = ((size_t)(b * 4096 + t)) * 256 + ch;
            const u32x4 vv = *(const u32x4*)(AV + off), gg = *(const u32x4*)(AG + off);
#pragma unroll
            for (int j = 0; j < 4; ++j) {
                const unsigned vw = vv[j], gw = gg[j];
                const float v0 = __builtin_bit_cast(float, vw << 16), v1 = __builtin_bit_cast(float, vw & 0xffff0000u);
                const float g0 = __builtin_bit_cast(float, gw << 16), g1 = __builtin_bit_cast(float, gw & 0xffff0000u);
                uv[2 * j] = v0 * sigmoid_f(g0); uv[2 * j + 1] = v1 * sigmoid_f(g1);
            }
        } else {
#pragma unroll
            for (int j = 0; j < 8; ++j) uv[j] = 0.f;
        }
        *(LAS f32x4*)(u + tt * 256 + ch) = (f32x4){uv[0], uv[1], uv[2], uv[3]};
        *(LAS f32x4*)(u + tt * 256 + ch + 4) = (f32x4){uv[4], uv[5], uv[6], uv[7]};
    }
    const int ch = tid & 255, half = tid >> 8;
    float w[31];
#pragma unroll
    for (int k = 0; k < 31; ++k) w[k] = cw[k * 256 + ch];
    const float bias = cb[ch];
    __syncthreads();
    for (int j = 0; j < 16; ++j) {
        const int tl = half * 16 + j;
        float acc = bias;
#pragma unroll
        for (int k = 0; k < 31; ++k) acc += w[k] * u[(tl + k) * 256 + ch];
        co[tl * 256 + ch] = acc;
    }
    __syncthreads();
    const f32x4 gv = *(const f32x4*)(cg_ + 4 * lane), bv = *(const f32x4*)(cbeta + 4 * lane);
#pragma unroll
    for (int j = 0; j < 4; ++j) {
        const int tl = wid * 4 + j;
        f32x4 v = *(const LAS f32x4*)(co + tl * 256 + 4 * lane);
        const float mean = wave_sum((v[0] + v[1]) + (v[2] + v[3])) * (1.f / 256.f);
        v = v - mean;
        const float var = wave_sum((v[0] * v[0] + v[1] * v[1]) + (v[2] * v[2] + v[3] * v[3])) * (1.f / 256.f);
        const float rstd = 1.0f / sqrtf(var + LN_EPS);
        float o[4];
#pragma unroll
        for (int e = 0; e < 4; ++e) o[e] = silu_f(v[e] * rstd * gv[e] + bv[e]);
        u32x2 wv; wv.x = cvtpk(o[0], o[1]); wv.y = cvtpk(o[2], o[3]);
        *(u32x2*)(YCAT + ((size_t)(b * 4096 + t0 + tl)) * DM + 4 * lane) = wv;
    }
    __syncthreads();
}

#define XB_TMO      128
#define XB_XCNT(j)  (256  + 64 * (j))
#define XB_XSUB(j)  (1280 + 64 * (j))
#define XB_XGEN(j)  (2304 + 64 * (j))
#define XB_TOP      3328
#define XB_TOPGEN   3392
#define XCD_BAR_WORDS 3456
#define XB_SPIN_CAP (1u << 18)

__device__ __forceinline__ unsigned xb_ld(unsigned* p)              { return __hip_atomic_load(p, __ATOMIC_RELAXED, __HIP_MEMORY_SCOPE_AGENT); }
__device__ __forceinline__ unsigned xb_add(unsigned* p, unsigned v) { return __hip_atomic_fetch_add(p, v, __ATOMIC_RELAXED, __HIP_MEMORY_SCOPE_AGENT); }
__device__ __forceinline__ unsigned xb_xcc_id() { return (unsigned)__builtin_amdgcn_s_getreg((3 << 11) | 20) & 0xFu; }
#define XB_SPIN(cond, bar) do { unsigned _sp = 0; while (cond) { __builtin_amdgcn_s_sleep(1); \
    if ((++_sp & 255u) == 0u) { if (xb_ld(&(bar)[XB_TMO])) break; if (_sp > XB_SPIN_CAP) { atomicAdd(&(bar)[XB_TMO], 1u); break; } } } } while (0)

struct XcdBarrier {
    unsigned* bar; unsigned x;
    volatile LAS unsigned* st;
};

__device__ __forceinline__ XcdBarrier xcd_barrier_post(unsigned* bar, volatile LAS unsigned* st) {
    XcdBarrier b; b.bar = bar; b.x = xb_xcc_id(); b.st = st;
    if (threadIdx.x == 0) (void)xb_add(&bar[XB_XCNT(b.x)], 1u);
    return b;
}
__device__ __forceinline__ void xcd_barrier_complete(unsigned* bar, unsigned x, unsigned& nloc, unsigned& nx) {
    const unsigned G = gridDim.x * gridDim.y * gridDim.z;
    unsigned sum, cnt, mine, sp = 0u;
    for (;;) {
        sum = 0u; cnt = 0u; mine = 0u;
#pragma unroll
        for (unsigned j = 0; j < 16; ++j) { const unsigned c = xb_ld(&bar[XB_XCNT(j)]); sum += c; cnt += (c > 0u) ? 1u : 0u; mine = (j == x) ? c : mine; }
        if (sum == G) break;
        __builtin_amdgcn_s_sleep(1);
        if ((++sp & 255u) == 0u) { if (xb_ld(&bar[XB_TMO])) break; if (sp > XB_SPIN_CAP) { atomicAdd(&bar[XB_TMO], 1u); break; } }
    }
    nloc = mine > 0u ? mine : 1u; nx = cnt > 0u ? cnt : 1u;
}

__device__ __forceinline__ void xcd_barrier(const XcdBarrier& b) {
    asm volatile("s_waitcnt vmcnt(0)" ::: "memory");
    __syncthreads();
    if (threadIdx.x == 0) {
        unsigned* bar = b.bar;
        __builtin_amdgcn_s_waitcnt(0);
        unsigned nloc = b.st[0], nx = b.st[1];
        if (nloc == 0u) { xcd_barrier_complete(bar, b.x, nloc, nx); b.st[0] = nloc; b.st[1] = nx; }
        const unsigned old = xb_add(&bar[XB_XSUB(b.x)], 1u);
        const unsigned gen = old / nloc;
        if (old + 1u == (gen + 1u) * nloc) {
            __builtin_amdgcn_fence(__ATOMIC_RELEASE, "agent");
            asm volatile("s_waitcnt vmcnt(0)" ::: "memory");
            const unsigned og = xb_add(&bar[XB_TOP], 1u);
            const unsigned tg = og / nx;
            if (og + 1u == (tg + 1u) * nx) xb_add(&bar[XB_TOPGEN], 1u);
            else XB_SPIN(xb_ld(&bar[XB_TOPGEN]) == tg, bar);
            __builtin_amdgcn_fence(__ATOMIC_ACQUIRE, "agent");
            xb_add(&bar[XB_XGEN(b.x)], 1u);
            asm volatile("s_waitcnt vmcnt(0)" ::: "memory");
        } else {
            XB_SPIN(xb_ld(&bar[XB_XGEN(b.x)]) == gen, bar);
            __builtin_amdgcn_fence(__ATOMIC_ACQUIRE, "agent");
            asm volatile("s_waitcnt vmcnt(0)" ::: "memory");
        }
    }
    __syncthreads();
}

#ifndef SYNC_REPS
#define SYNC_REPS 1
#endif
#ifndef MIX_REPS
#define MIX_REPS 1
#endif
#ifndef MIX2_LO
#define MIX2_LO 0
#endif
#ifndef MIX2_HI
#define MIX2_HI 1024
#endif
#ifndef G1_REPS
#define G1_REPS 1
#endif
#ifndef G3_REPS
#define G3_REPS 1
#endif
#ifndef PRO_REPS
#define PRO_REPS 1
#endif
#define GSYNC() do { for (int r_ = 0; r_ < SYNC_REPS; ++r_) xcd_barrier(xbar); } while (0)
__global__ void __launch_bounds__(NTHR, 2) hybrid_fwd(Args a) {
    extern __shared__ __attribute__((aligned(16))) unsigned char lds_raw[];
    LAS unsigned char* lds = (LAS unsigned char*)lds_raw;
    cg::grid_group grid = cg::this_grid();
    const int tid = threadIdx.x, G = gridDim.x, bx = blockIdx.x;
    unsigned char* ws = a.ws;
    bf16* HB = (bf16*)(ws + WS_HB); bf16* ACT = (bf16*)(ws + WS_ACT); bf16* YCAT = (bf16*)(ws + WS_YCAT);
    bf16 *AV = (bf16*)(ws + WS_AV), *AG = (bf16*)(ws + WS_AG), *BQ = (bf16*)(ws + WS_BQ), *BK = (bf16*)(ws + WS_BK), *BVT = (bf16*)(ws + WS_BVT), *CQ = (bf16*)(ws + WS_CQ), *CK = (bf16*)(ws + WS_CK),
         *CVT1 = (bf16*)(ws + WS_CVT1), *CVT4 = (bf16*)(ws + WS_CVT4), *CVT16 = (bf16*)(ws + WS_CVT16);
    float* lgf = (float*)(ws + WS_LGF); const float* rope = (const float*)(ws + WS_ROPE);
    unsigned* ctl = (unsigned*)(ws + WS_CTL);
    float* H = a.out;

    if (tid < 2) ((volatile LAS unsigned*)(lds + LDS_MISC + 64))[tid] = 0u;
    for (int r_ = 0; r_ < PRO_REPS; ++r_) prologue(a, lds);
    grid.sync();
    XcdBarrier xbar = xcd_barrier_post(ctl + CW_BAR, (volatile LAS unsigned*)(lds + LDS_MISC + 64));

    for (int l = 0; l < 2; ++l) {
        for (int j = 0; j < 3; ++j) {
            if (j != 1) {
                const int fi = l * 2 + (j >> 1);
                {
                    pg8::Gemm g{HB, (const bf16*)(ws + WS_W1T) + (size_t)fi * 5632 * 1024, MTOK, 2 * DFF, DM};
                    pg8::StaticOrder S; S.init(MTOK, 2 * DFF, G, bx);
                    EpiSwiGLU E{ACT};
                    for (int r_ = 0; r_ < G1_REPS; ++r_) pg8::gemm_phase<EpiSwiGLU, pg8::StaticOrder, true, true>(lds, g, S, E);
                }
                GSYNC();
                {
                    pg8::Gemm g{ACT, (const bf16*)(ws + WS_W2T) + (size_t)fi * 1024 * DFF, MTOK, DM, DFF};
                    pg8::StaticOrder S; S.init(MTOK, DM, G, bx);
                    EpiResid E{(l == 0 && j == 0) ? a.x : (const float*)H, H, 0.5f};
#ifndef NO_G2
                    pg8::gemm_phase<EpiResid, pg8::StaticOrder, true, true>(lds, g, S, E);
#endif
                }
                GSYNC();
            } else {
                {
                    pg8::Gemm g{HB, (const bf16*)(ws + WS_WINT) + (size_t)l * NPROJ * 1024, MTOK, NPROJ, DM};
                    pg8::StaticOrder S; S.init(MTOK, NPROJ, G, bx);
                    EpiProj E{AV, AG, BQ, BK, BVT, CQ, CK, CVT1, CVT4, CVT16, rope};
                    for (int r_ = 0; r_ < G3_REPS; ++r_) pg8::gemm_phase<EpiProj, pg8::StaticOrder, true, true>(lds, g, S, E);
                }
                GSYNC();
                {
                    LAS int* itemw = (LAS int*)(lds + LDS_MISC);
                    for (int rep = 0; rep < MIX_REPS; ++rep) {
                    const int lo = rep == 0 ? 0 : MIX2_LO, hi = rep == 0 ? 1024 : MIX2_HI;
                    if (rep) grid.sync();
                    for (;;) {
                        __syncthreads();
                        if (tid == 0) *itemw = (int)atomicAdd(ctl + l + 8 * rep, 1u) + lo;
                        __syncthreads();
                        const int it = *itemw;
                        if (it >= hi) break;
                        if (it < 256) { const int qb = 15 - (it >> 4), bhh = it & 15;
#ifndef NO_FOX
 fox_unit(lds, bhh >> 2, bhh & 3, qb, BQ, BK, BVT, lgf, YCAT);
#endif
 }
                        else if (it < 512) { const int q = it - 256;
#ifndef NO_DIL
 dil_unit(q >> 6, (q >> 3) & 7, q & 7, CQ, CK, CVT1, CVT4, CVT16, YCAT);
#endif
 }
                        else { const int q = it - 512;
#ifndef NO_CONV
 conv_unit(lds, q >> 7, q & 127, AV, AG, a.conv_w + (size_t)l * 31 * 256, a.conv_b + l * 256, a.conv_g + l * 256, a.conv_beta + l * 256, YCAT);
#endif
 }
                    }
                    }
                }
                GSYNC();
                {
                    pg8::Gemm g{YCAT, (const bf16*)(ws + WS_WOT) + (size_t)l * 1024 * 1024, MTOK, DM, DM};
                    pg8::StaticOrder S; S.init(MTOK, DM, G, bx);
                    EpiResid E{(const float*)H, H, 1.0f};
#ifndef NO_G4
                    pg8::gemm_phase<EpiResid, pg8::StaticOrder, true, true>(lds, g, S, E);
#endif
                }
                GSYNC();
            }
#ifndef NO_LN
            ln_phase(H, HB, a.ln_g + (size_t)(l * 3 + j) * DM, a.ln_b + (size_t)(l * 3 + j) * DM, j == 0, a.w_in + (size_t)l * 1024 * INCOLS, a.fbias + l * 4, lgf, lds);
#endif
            if (!(l == 1 && j == 2)) GSYNC();
        }
    }
}

extern "C" void kernel_launch(void* const* d_in, const int* in_sizes, int n_in, void* d_out, int out_size, void* d_ws, size_t ws_size, hipStream_t stream) {
    static int grid_blocks = 0;
    if (grid_blocks == 0) {
        if (n_in != 12 || out_size != MTOK * DM || ws_size < WS_END) { fprintf(stderr, "kernel_launch: unexpected problem (n_in %d out %d ws %zu)\n", n_in, out_size, ws_size); grid_blocks = -1; return; }
        int dev = 0, cus = 0, per_cu = 0;
        hipGetDevice(&dev);
        hipDeviceGetAttribute(&cus, hipDeviceAttributeMultiprocessorCount, dev);
        if (hipFuncSetAttribute((const void*)hybrid_fwd, hipFuncAttributeMaxDynamicSharedMemorySize, LDS_BYTES) != hipSuccess) { fprintf(stderr, "hipFuncSetAttribute failed\n"); grid_blocks = -1; return; }
        if (hipOccupancyMaxActiveBlocksPerMultiprocessor(&per_cu, (const void*)hybrid_fwd, NTHR, LDS_BYTES) != hipSuccess || per_cu < 1) { fprintf(stderr, "occupancy query failed (%d)\n", per_cu); (void)hipGetLastError(); per_cu = 1; }
        grid_blocks = cus * 1;
    }
    if (grid_blocks < 0) return;
    Args a{};
    a.x = (const float*)d_in[0]; a.w_in = (const float*)d_in[1]; a.w_o = (const float*)d_in[2]; a.fbias = (const float*)d_in[3]; a.conv_w = (const float*)d_in[4]; a.conv_b = (const float*)d_in[5];
    a.conv_g = (const float*)d_in[6]; a.conv_beta = (const float*)d_in[7]; a.ffn_w_in = (const float*)d_in[8]; a.ffn_w_out = (const float*)d_in[9]; a.ln_g = (const float*)d_in[10]; a.ln_b = (const float*)d_in[11];
    a.out = (float*)d_out; a.ws = (unsigned char*)d_ws;
    void* args[] = {&a};
    hipError_t e = hipLaunchCooperativeKernel((const void*)hybrid_fwd, dim3(grid_blocks), dim3(NTHR), args, LDS_BYTES, stream);
    if (e != hipSuccess) fprintf(stderr, "cooperative launch failed: %s (grid %d)\n", hipGetErrorString(e), grid_blocks);
}
```

```cpp
#include <hip/hip_runtime.h>
#include <hip/hip_cooperative_groups.h>
#include <cstdio>
#include <cstdint>
#include <cmath>
namespace cg = cooperative_groups;
namespace pg8 {
#define PG8_LAS __attribute__((address_space(3)))
typedef unsigned short bf16_t;
typedef short bf16x8 __attribute__((ext_vector_type(8)));
typedef float f32x4 __attribute__((ext_vector_type(4)));
typedef unsigned u32x4 __attribute__((ext_vector_type(4)));
constexpr int BM = 256, BK = 64, HALF = 128, HTB = HALF * BK * 2  , STAGE_BYTES = 8 * HTB, NXCD = 8, WGM = 8;

__host__ __device__ __forceinline__ int lds_byte(int r, int c) { const int st = (r >> 4) * 2 + (c >> 5), rr = r & 15, cc = c & 31, ob = rr * 64 + cc * 2; return st * 1024 + (ob ^ (((ob >> 9) & 1) << 5)); }
__host__ __device__ __forceinline__ void stage_rc(int b, int& R, int& C) { const int st = b / 1024, sb = b % 1024, swz = sb ^ (((sb >> 9) & 1) << 5); R = (st >> 1) * 16 + swz / 64; C = (st & 1) * 32 + (swz % 64) / 2; }
__host__ __device__ __forceinline__ int perm32(int rho) { const int n = rho >> 4, i = rho & 15; return 8 * (i >> 2) + 4 * n + (i & 3); }

struct Unit { int pm, pn; };
struct Gemm { const bf16_t* A; const bf16_t* Bt; int M, N, K; };

struct StaticOrder {
    int nM, nN, nwg, G, c;
    __host__ __device__ void init(int M, int N, int G_, int c_) { nM = M / BM; nN = N / BM; nwg = nM * nN; G = G_; c = c_; }
    __host__ __device__ bool next(int i, Unit& u) const {
        const long L = (long)i * G + c; if (L >= nwg) return false;
        int wgid = (int)L; { const int q = nwg / NXCD, r = nwg % NXCD, xcd = wgid % NXCD, off = wgid / NXCD; wgid = (xcd < r ? xcd * (q + 1) : r * (q + 1) + (xcd - r) * q) + off; }
        const int nig = WGM * nN, gid = wgid / nig, fm = gid * WGM, gsz = (nM - fm) < WGM ? (nM - fm) : WGM;
        u.pm = fm + ((wgid % nig) % gsz); u.pn = (wgid % nig) / gsz; return true;
    }
    __device__ __forceinline__ void a_ready(const Unit&) const {}
    __device__ __forceinline__ void done(const Unit&) const {}
};

__device__ __forceinline__ unsigned cvt_pk_bf16(float lo, float hi) { unsigned r; asm volatile("v_cvt_pk_bf16_f32 %0, %1, %2" : "=v"(r) : "v"(lo), "v"(hi)); return r; }
typedef float f32x2 __attribute__((ext_vector_type(2)));
template <class Epi, class Sched, bool ALIGN_EPI = false, bool SP2 = false>
__device__ __forceinline__ void gemm_phase(PG8_LAS unsigned char* lds, const Gemm g, const Sched& S, const Epi& E) {
    int tid_ = threadIdx.x; asm volatile("" : "+v"(tid_));
    const int tid = tid_, wid = __builtin_amdgcn_readfirstlane(tid >> 6), lane = tid & 63, wr = wid >> 2, wc = wid & 3, fr = lane & 15, fq = lane >> 4;
    const int K = g.K, nt = K / BK;
    unsigned voffA[2], voffB[2];
#pragma unroll
    for (int i = 0; i < 2; ++i) { int R, C; stage_rc(tid * 16 + i * 8192, R, C); const int Rb = Epi::PERM ? ((R & ~31) + perm32(R & 31)) : R;
        voffA[i] = (unsigned)(R * K + C) * 2u; voffB[i] = (unsigned)(Rb * K + C) * 2u; }
    const size_t kstep = (size_t)(BK * 2);
    const size_t hstep = (size_t)HALF * K * 2;
    const size_t tstep = 2 * hstep;
    const unsigned ldsw = (unsigned)wid * 1024u;
    const int aoff = lds_byte(wr * 64 + fr, fq * 8), boff = lds_byte(wc * 32 + fr, fq * 8);
#define PG8_SA(b, h) (((b) * 2 + (h)) * HTB)
#define PG8_SB(b, h) ((4 + (b) * 2 + (h)) * HTB)
#define PG8_STAGE(bufoff, gbase, voff) do { _Pragma("unroll") for (int _i = 0; _i < 2; ++_i) \
        __builtin_amdgcn_global_load_lds((const unsigned*)((const char*)(gbase) + (voff)[_i]), (PG8_LAS unsigned*)(lds + (bufoff) + ldsw + _i * 8192), 16, 0, 0); } while (0)
#define PG8_LDA(dst, b, h) do { _Pragma("unroll") for (int m = 0; m < 4; ++m) _Pragma("unroll") for (int k = 0; k < 2; ++k) dst[m][k] = *(const PG8_LAS bf16x8*)(lds + PG8_SA(b, h) + aoff + m * 2048 + k * 1024); } while (0)
#define PG8_LDB(dst, b, h) do { _Pragma("unroll") for (int n = 0; n < 2; ++n) _Pragma("unroll") for (int k = 0; k < 2; ++k) dst[n][k] = *(const PG8_LAS bf16x8*)(lds + PG8_SB(b, h) + boff + n * 2048 + k * 1024); } while (0)
#define PG8_MMA(ai, bj, At, Bt) do { __builtin_amdgcn_s_setprio(1); _Pragma("unroll") for (int m = 0; m < 4; ++m) _Pragma("unroll") for (int n = 0; n < 2; ++n) _Pragma("unroll") for (int k = 0; k < 2; ++k) \
        acc[ai][bj][m][n] = __builtin_amdgcn_mfma_f32_16x16x32_bf16(Bt[n][k], At[m][k], acc[ai][bj][m][n], 0, 0, 0); __builtin_amdgcn_s_setprio(0); } while (0)
#define PG8_WAIT_V(n) asm volatile("s_waitcnt vmcnt(" #n ")" ::: "memory")
#define PG8_WAIT_L(n) asm volatile("s_waitcnt lgkmcnt(" #n ")" ::: "memory")
#define PG8_BAR __builtin_amdgcn_s_barrier()
#define PG8_SCHED __builtin_amdgcn_sched_barrier(0)
    Unit cur, nxt; int ui = 0;
    if (!S.next(0, cur)) return;
    f32x4 acc[2][2][4][2];
#pragma unroll
    for (int a = 0; a < 2; ++a)
#pragma unroll
        for (int b = 0; b < 2; ++b)
#pragma unroll
            for (int m = 0; m < 4; ++m)
#pragma unroll
                for (int n = 0; n < 2; ++n) acc[a][b][m][n] = (f32x4){0.f, 0.f, 0.f, 0.f};
    bf16x8 At[4][2], B0[2][2], B1[2][2];
    const char* cA = (const char*)g.A + (size_t)cur.pm * tstep; const char* cB = (const char*)g.Bt + (size_t)cur.pn * tstep;
    S.a_ready(cur);
    if constexpr (SP2) {
        PG8_STAGE(PG8_SB(0, 0), cB, voffB); PG8_STAGE(PG8_SB(0, 1), cB + hstep, voffB); PG8_STAGE(PG8_SA(0, 0), cA, voffA); PG8_STAGE(PG8_SA(0, 1), cA + hstep, voffA);
        if (wr == 1) PG8_BAR;
        PG8_WAIT_V(2); PG8_BAR;
        PG8_STAGE(PG8_SB(1, 0), cB + kstep, voffB); PG8_STAGE(PG8_SA(1, 0), cA + kstep, voffA); PG8_STAGE(PG8_SB(1, 1), cB + hstep + kstep, voffB);
        PG8_WAIT_V(6); PG8_BAR;
    } else {
        PG8_STAGE(PG8_SB(0, 0), cB, voffB); PG8_STAGE(PG8_SA(0, 0), cA, voffA); PG8_STAGE(PG8_SB(0, 1), cB + hstep, voffB); PG8_STAGE(PG8_SA(0, 1), cA + hstep, voffA);
        if (wr == 1) PG8_BAR;
        PG8_WAIT_V(4); PG8_BAR;
        PG8_STAGE(PG8_SB(1, 0), cB + kstep, voffB); PG8_STAGE(PG8_SA(1, 0), cA + kstep, voffA); PG8_STAGE(PG8_SB(1, 1), cB + hstep + kstep, voffB);
        PG8_WAIT_V(6); PG8_BAR;
    }
    for (;;) {
        const bool has_next = S.next(ui + 1, nxt);
        const char* nA = has_next ? (const char*)g.A + (size_t)nxt.pm * tstep : cA; const char* nB = has_next ? (const char*)g.Bt + (size_t)nxt.pn * tstep : cB;
        for (int t = 0; t < nt; t += 2) {
            const bool last = (t == nt - 2);
            const char* a1 = cA + (size_t)(t + 1) * kstep;
            const char* a2 = last ? nA : cA + (size_t)(t + 2) * kstep; const char* b2 = last ? nB : cB + (size_t)(t + 2) * kstep;
            const char* a3 = a2 + kstep; const char* b3 = b2 + kstep;
            if (last && has_next) S.a_ready(nxt);
            if constexpr (SP2) {
            PG8_LDB(B0, 0, 0); PG8_LDB(B1, 0, 1); PG8_SCHED; PG8_LDA(At, 0, 0); PG8_STAGE(PG8_SA(1, 1), a1 + hstep, voffA);
            PG8_WAIT_V(8); PG8_WAIT_L(0); PG8_BAR; PG8_MMA(0, 0, At, B0); PG8_MMA(0, 1, At, B1); PG8_BAR; PG8_SCHED;
            PG8_LDA(At, 0, 1); PG8_STAGE(PG8_SB(0, 0), b2, voffB); PG8_STAGE(PG8_SB(0, 1), b2 + hstep, voffB); PG8_STAGE(PG8_SA(0, 0), a2, voffA);
            PG8_WAIT_V(8); PG8_WAIT_L(0); PG8_BAR; PG8_MMA(1, 0, At, B0); PG8_MMA(1, 1, At, B1); PG8_BAR; PG8_SCHED;
            PG8_LDB(B0, 1, 0); PG8_LDB(B1, 1, 1); PG8_SCHED; PG8_LDA(At, 1, 0); PG8_STAGE(PG8_SA(0, 1), a2 + hstep, voffA);
            PG8_WAIT_V(8); PG8_WAIT_L(0); PG8_BAR; PG8_MMA(0, 0, At, B0); PG8_MMA(0, 1, At, B1); PG8_BAR; PG8_SCHED;
            PG8_LDA(At, 1, 1); PG8_STAGE(PG8_SB(1, 0), b3, voffB); PG8_STAGE(PG8_SB(1, 1), b3 + hstep, voffB); PG8_STAGE(PG8_SA(1, 0), a3, voffA);
            PG8_WAIT_V(8); PG8_WAIT_L(0); PG8_BAR; PG8_MMA(1, 0, At, B0); PG8_MMA(1, 1, At, B1); PG8_BAR; PG8_SCHED;
            } else {
            PG8_LDB(B0, 0, 0); PG8_SCHED; PG8_LDA(At, 0, 0); PG8_STAGE(PG8_SA(1, 1), a1 + hstep, voffA);
            PG8_WAIT_L(8); PG8_BAR; PG8_WAIT_L(0); PG8_MMA(0, 0, At, B0); PG8_BAR; PG8_SCHED;
            PG8_LDB(B1, 0, 1); PG8_STAGE(PG8_SB(0, 0), b2, voffB);
            PG8_BAR; PG8_WAIT_L(0); PG8_MMA(0, 1, At, B1); PG8_BAR;
            PG8_LDA(At, 0, 1); PG8_STAGE(PG8_SA(0, 0), a2, voffA);
            PG8_BAR; PG8_WAIT_L(0); PG8_MMA(1, 0, At, B0); PG8_BAR; PG8_SCHED;
            PG8_STAGE(PG8_SB(0, 1), b2 + hstep, voffB);
            PG8_WAIT_V(6); PG8_BAR; PG8_MMA(1, 1, At, B1); PG8_BAR;
            PG8_LDB(B0, 1, 0); PG8_SCHED; PG8_LDA(At, 1, 0); PG8_STAGE(PG8_SA(0, 1), a2 + hstep, voffA);
            PG8_WAIT_L(8); PG8_BAR; PG8_WAIT_L(0); PG8_MMA(0, 0, At, B0); PG8_BAR; PG8_SCHED;
            PG8_LDB(B1, 1, 1); PG8_STAGE(PG8_SB(1, 0), b3, voffB);
            PG8_BAR; PG8_WAIT_L(0); PG8_MMA(0, 1, At, B1); PG8_BAR;
            PG8_LDA(At, 1, 1); PG8_STAGE(PG8_SA(1, 0), a3, voffA);
            PG8_BAR; PG8_WAIT_L(0); PG8_MMA(1, 0, At, B0); PG8_BAR; PG8_SCHED;
            PG8_STAGE(PG8_SB(1, 1), b3 + hstep, voffB);
            PG8_WAIT_V(6); PG8_BAR; PG8_MMA(1, 1, At, B1); PG8_BAR;
            }
        }
        if constexpr (ALIGN_EPI) { if (wr == 0) PG8_BAR; }
        if constexpr (!Epi::AFTER_DRAIN) { E(acc, cur, wr, wc, fr, fq); S.done(cur); }
        if (!has_next) break;
#pragma unroll
        for (int a = 0; a < 2; ++a)
#pragma unroll
            for (int b = 0; b < 2; ++b)
#pragma unroll
                for (int m = 0; m < 4; ++m)
#pragma unroll
                    for (int n = 0; n < 2; ++n) acc[a][b][m][n] = (f32x4){0.f, 0.f, 0.f, 0.f};
        cur = nxt; cA = nA; cB = nB; ++ui;
        if constexpr (ALIGN_EPI) { if (wr == 1) PG8_BAR; }
    }
    PG8_WAIT_V(0);
    if constexpr (!ALIGN_EPI) { if (wr == 0) PG8_BAR; }
    PG8_BAR;
    if constexpr (Epi::AFTER_DRAIN) { E.fused(acc, cur, wr, wc, fr, fq, lds, wid, lane); S.done(cur); }
#undef PG8_SA
#undef PG8_SB
#undef PG8_STAGE
#undef PG8_LDA
#undef PG8_LDB
#undef PG8_MMA
#undef PG8_WAIT_V
#undef PG8_WAIT_L
#undef PG8_BAR
#undef PG8_SCHED
}
}

#define LAS __attribute__((address_space(3)))
typedef unsigned short bf16;
typedef short bf16x8 __attribute__((ext_vector_type(8)));
typedef short s16x4 __attribute__((ext_vector_type(4)));
typedef float f32x4 __attribute__((ext_vector_type(4)));
typedef float f32x16 __attribute__((ext_vector_type(16)));
typedef unsigned u32x4 __attribute__((ext_vector_type(4)));
typedef unsigned u32x2 __attribute__((ext_vector_type(2)));
typedef float f32x2_t __attribute__((ext_vector_type(2)));
typedef __bf16 bf16x2_t __attribute__((ext_vector_type(2)));

constexpr int NB = 4, SEQ = 4096, DM = 1024, MTOK = NB * SEQ, DFF = 2816, NPROJ = 2816, INCOLS = 2820;
constexpr float ALPHA = 1.41421356237309515f, LN_EPS = 1e-5f, LOG2E = 1.4426950408889634f;
constexpr size_t MiB = 1u << 20;
constexpr size_t WS_CTL = 0, WS_ROPE = 1 * MiB, WS_W1T = 2 * MiB, WS_W2T = 46 * MiB, WS_WINT = 68 * MiB, WS_WOT = 79 * MiB, WS_HB = 83 * MiB, WS_LGF = 115 * MiB,
                 WS_ACT = 116 * MiB, WS_AV = 116 * MiB, WS_AG = 124 * MiB, WS_BQ = 132 * MiB, WS_BK = 140 * MiB, WS_BVT = 148 * MiB, WS_CQ = 156 * MiB, WS_CK = 172 * MiB,
                 WS_CVT1 = 188 * MiB, WS_CVT4 = 204 * MiB, WS_CVT16 = 220 * MiB, WS_YCAT = 236 * MiB, WS_END = 268 * MiB;
constexpr int LDS_BYTES = 147456, LDS_MISC = 135168;
constexpr int NTHR = 512;
constexpr int CW_BAR = 4096;
#define XCD_BAR_WORDS 3456

__device__ __forceinline__ unsigned cvtpk(float lo, float hi) { f32x2_t v = {lo, hi}; bf16x2_t b = __builtin_convertvector(v, bf16x2_t); return __builtin_bit_cast(unsigned, b); }
__device__ __forceinline__ unsigned short f2bf(float f) { return (unsigned short)(cvtpk(f, 0.f) & 0xffffu); }
__device__ __forceinline__ float bf2f(unsigned short b) { return __builtin_bit_cast(float, (unsigned)b << 16); }
__device__ __forceinline__ float wave_sum(float v) {
#pragma unroll
    for (int o = 1; o < 64; o <<= 1) v += __shfl_xor(v, o);
    return v;
}
__device__ __forceinline__ float silu_f(float g) { return g * __builtin_amdgcn_rcpf(1.f + __expf(-g)); }
__device__ __forceinline__ float sigmoid_f(float g) { return __builtin_amdgcn_rcpf(1.f + __expf(-g)); }

struct EpiSwiGLU {
    static constexpr bool PERM = true, AFTER_DRAIN = false;
    bf16* O;
    __device__ __forceinline__ void operator()(const pg8::f32x4 (&acc)[2][2][4][2], const pg8::Unit& u, int wr, int wc, int fr, int fq) const {
        const int row0 = u.pm * 256 + wr * 64 + fr, col0 = u.pn * 128 + wc * 32 + 8 * fq;
#pragma unroll
        for (int ai = 0; ai < 2; ++ai)
#pragma unroll
            for (int m = 0; m < 4; ++m) {
                const pg8::f32x4 g0 = acc[ai][0][m][0], g1 = acc[ai][0][m][1], u0 = acc[ai][1][m][0], u1 = acc[ai][1][m][1];
                u32x4 w;
                w.x = pg8::cvt_pk_bf16(silu_f(g0[0]) * u0[0], silu_f(g0[1]) * u0[1]); w.y = pg8::cvt_pk_bf16(silu_f(g0[2]) * u0[2], silu_f(g0[3]) * u0[3]);
                w.z = pg8::cvt_pk_bf16(silu_f(g1[0]) * u1[0], silu_f(g1[1]) * u1[1]); w.w = pg8::cvt_pk_bf16(silu_f(g1[2]) * u1[2], silu_f(g1[3]) * u1[3]);
                *(u32x4*)(O + (size_t)(row0 + ai * 128 + m * 16) * DFF + col0) = w;
            }
    }
};
struct EpiResid {
    static constexpr bool PERM = true, AFTER_DRAIN = false;
    const float* res; float* out; float scale;
    __device__ __forceinline__ void operator()(const pg8::f32x4 (&acc)[2][2][4][2], const pg8::Unit& u, int wr, int wc, int fr, int fq) const {
        const int row0 = u.pm * 256 + wr * 64 + fr, col0 = u.pn * 256 + wc * 32 + 8 * fq;
#pragma unroll
        for (int ai = 0; ai < 2; ++ai)
#pragma unroll
            for (int m = 0; m < 4; ++m)
#pragma unroll
                for (int bj = 0; bj < 2; ++bj) {
                    const size_t off = (size_t)(row0 + ai * 128 + m * 16) * DM + col0 + bj * 128;
                    const f32x4 r0 = *(const f32x4*)(res + off), r1 = *(const f32x4*)(res + off + 4);
                    f32x4 o0, o1;
#pragma unroll
                    for (int e = 0; e < 4; ++e) { o0[e] = ALPHA * r0[e] + scale * acc[ai][bj][m][0][e]; o1[e] = ALPHA * r1[e] + scale * acc[ai][bj][m][1][e]; }
                    *(f32x4*)(out + off) = o0; *(f32x4*)(out + off + 4) = o1;
                }
    }
};
struct EpiProj {
    static constexpr bool PERM = true, AFTER_DRAIN = false;
    bf16 *AV, *AG, *BQ, *BK, *BVT, *CQ, *CK, *CVT1, *CVT4, *CVT16; const float* rope;
    __device__ __forceinline__ void operator()(const pg8::f32x4 (&acc)[2][2][4][2], const pg8::Unit& u, int wr, int wc, int fr, int fq) const {
        const int pn = u.pn;
        const int rbase = u.pm * 256 + wr * 64;
        if (pn <= 3) {
#pragma unroll
            for (int ai = 0; ai < 2; ++ai)
#pragma unroll
                for (int m = 0; m < 4; ++m)
#pragma unroll
                    for (int bj = 0; bj < 2; ++bj) {
                        const int row = rbase + ai * 128 + m * 16 + fr, cl = bj * 128 + wc * 32 + 8 * fq;
                        const pg8::f32x4 v0 = acc[ai][bj][m][0], v1 = acc[ai][bj][m][1];
                        u32x4 w; w.x = pg8::cvt_pk_bf16(v0[0], v0[1]); w.y = pg8::cvt_pk_bf16(v0[2], v0[3]); w.z = pg8::cvt_pk_bf16(v1[0], v1[1]); w.w = pg8::cvt_pk_bf16(v1[2], v1[3]);
                        if (pn <= 1) { bf16* dst = (pn == 0 ? AV : AG) + (size_t)row * 256 + cl; *(u32x4*)dst = w; }
                        else { const int b = row >> 12, s = row & 4095, head = cl >> 6, dd = cl & 63;
                               bf16* dst = (pn == 2 ? BQ : BK) + ((size_t)((b * 4 + head) * 4096 + s)) * 64 + dd; *(u32x4*)dst = w; }
                    }
        } else if (pn == 4) {
#pragma unroll
            for (int ai = 0; ai < 2; ++ai)
#pragma unroll
                for (int m = 0; m < 4; ++m)
#pragma unroll
                    for (int bj = 0; bj < 2; ++bj) {
                        const int row = rbase + ai * 128 + m * 16 + fr, cl = bj * 128 + wc * 32 + 8 * fq;
                        const int b = row >> 12, s = row & 4095, head = cl >> 6, dd = cl & 63;
                        bf16* dst = BVT + ((size_t)((b * 4 + head) * 64 + dd)) * 4096 + s;
#pragma unroll
                        for (int n = 0; n < 2; ++n)
#pragma unroll
                            for (int e = 0; e < 4; ++e) dst[(size_t)(4 * n + e) * 4096] = f2bf(acc[ai][bj][m][n][e]);
                    }
        } else if (pn <= 8) {
            const bool isq = pn <= 6; const float sc = isq ? 0.125f * LOG2E : 1.0f;   const int hb = ((pn - 5) & 1) * 4;
            bf16* base = isq ? CQ : CK;
#pragma unroll
            for (int ai = 0; ai < 2; ++ai)
#pragma unroll
                for (int m = 0; m < 4; ++m)
#pragma unroll
                    for (int bj = 0; bj < 2; ++bj) {
                        const int row = rbase + ai * 128 + m * 16 + fr, cl = bj * 128 + wc * 32 + 8 * fq;
                        const int b = row >> 12, s = row & 4095, head = hb + (cl >> 6), dd = cl & 63, i0 = dd >> 1;
                        const f32x4 c4 = *(const f32x4*)(rope + (size_t)s * 32 + i0), s4 = *(const f32x4*)(rope + 4096 * 32 + (size_t)s * 32 + i0);
                        const pg8::f32x4 v0 = acc[ai][bj][m][0], v1 = acc[ai][bj][m][1];
                        u32x4 w;
                        w.x = pg8::cvt_pk_bf16((v0[0] * c4[0] - v0[1] * s4[0]) * sc, (v0[1] * c4[0] + v0[0] * s4[0]) * sc);
                        w.y = pg8::cvt_pk_bf16((v0[2] * c4[1] - v0[3] * s4[1]) * sc, (v0[3] * c4[1] + v0[2] * s4[1]) * sc);
                        w.z = pg8::cvt_pk_bf16((v1[0] * c4[2] - v1[1] * s4[2]) * sc, (v1[1] * c4[2] + v1[0] * s4[2]) * sc);
                        w.w = pg8::cvt_pk_bf16((v1[2] * c4[3] - v1[3] * s4[3]) * sc, (v1[3] * c4[3] + v1[2] * s4[3]) * sc);
                        *(u32x4*)(base + ((size_t)((b * 8 + head) * 4096 + s)) * 64 + dd) = w;
                    }
        } else {
            const int hb = (pn - 9) * 4;
#pragma unroll
            for (int ai = 0; ai < 2; ++ai)
#pragma unroll
                for (int bj = 0; bj < 2; ++bj) {
                    const int cl = bj * 128 + wc * 32 + 8 * fq, head = hb + (cl >> 6), dd = cl & 63;
                    const int row_b = rbase + ai * 128, b = row_b >> 12, sb = row_b & 4095;
                    bf16* p1 = CVT1 + ((size_t)((b * 8 + head) * 64 + dd)) * 4096;
                    bf16* p4 = CVT4 + ((size_t)((b * 8 + head) * 64 + dd)) * 4096;
                    bf16* p16 = CVT16 + ((size_t)((b * 8 + head) * 64 + dd)) * 4096;
#pragma unroll
                    for (int n = 0; n < 2; ++n)
#pragma unroll
                        for (int e = 0; e < 4; ++e) {
                            const size_t co = (size_t)(4 * n + e) * 4096;
                            const float x0 = acc[ai][bj][0][n][e], x1 = acc[ai][bj][1][n][e], x2 = acc[ai][bj][2][n][e], x3 = acc[ai][bj][3][n][e];
                            u32x2 w16; w16.x = pg8::cvt_pk_bf16(x0, x1); w16.y = pg8::cvt_pk_bf16(x2, x3);
                            *(u32x2*)(p16 + co + fr * 256 + (sb >> 4)) = w16;
                            const unsigned short h0 = (unsigned short)(w16.x & 0xffffu), h1 = (unsigned short)(w16.x >> 16), h2 = (unsigned short)(w16.y & 0xffffu), h3 = (unsigned short)(w16.y >> 16);
                            p1[co + sb + fr] = h0; p1[co + sb + 16 + fr] = h1; p1[co + sb + 32 + fr] = h2; p1[co + sb + 48 + fr] = h3;
                            bf16* q4 = p4 + co + (fr & 3) * 1024 + ((sb + fr) >> 2);
                            q4[0] = h0; q4[4] = h1; q4[8] = h2; q4[12] = h3;
                        }
                }
        }
    }
};

struct Args {
    const float *x, *w_in, *w_o, *fbias, *conv_w, *conv_b, *conv_g, *conv_beta, *ffn_w_in, *ffn_w_out, *ln_g, *ln_b;
    float* out; unsigned char* ws;
};

__device__ __forceinline__ int src_col(int mode, int n) {
    if (mode == 1) return ((n & 255) >> 7) * DFF + (n >> 8) * 128 + (n & 127);
    if (mode == 2) { if (n < 1280) return n; const int np = n - 1280; if (np < 1024) { const int p = np & 63; return 1284 + (np & ~63) + (p >> 1) + 32 * (p & 1); } return 1284 + np; }
    return n;
}
__device__ __forceinline__ void transpose_item(const float* __restrict__ W, int K, int Nsrc, bf16* __restrict__ Wt, int mode, int kb, int nb, LAS float* t, int tid) {
    const int k0 = kb * 64, n0 = nb * 64, nl = tid & 63, sc = src_col(mode, n0 + nl);
#pragma unroll
    for (int i = 0; i < 8; ++i) { const int kk = (tid >> 6) + 8 * i; t[kk * 65 + nl] = W[(size_t)(k0 + kk) * Nsrc + sc]; }
    __syncthreads();
    const int n2 = tid >> 3, kc = (tid & 7) * 8;
    u32x4 w;
    w.x = cvtpk(t[(kc + 0) * 65 + n2], t[(kc + 1) * 65 + n2]); w.y = cvtpk(t[(kc + 2) * 65 + n2], t[(kc + 3) * 65 + n2]);
    w.z = cvtpk(t[(kc + 4) * 65 + n2], t[(kc + 5) * 65 + n2]); w.w = cvtpk(t[(kc + 6) * 65 + n2], t[(kc + 7) * 65 + n2]);
    *(u32x4*)(Wt + (size_t)(n0 + n2) * K + k0 + kc) = w;
    __syncthreads();
}
__device__ __forceinline__ void prologue(const Args& a, LAS unsigned char* lds) {
    const int tid = threadIdx.x, G = gridDim.x, bx = blockIdx.x;
    unsigned char* ws = a.ws;
    if (bx == 0) { if (tid < 64) ((unsigned*)(ws + WS_CTL))[tid] = 0u;
        for (int i = tid; i < XCD_BAR_WORDS; i += NTHR) ((unsigned*)(ws + WS_CTL))[CW_BAR + i] = 0u; }
    { float* rc = (float*)(ws + WS_ROPE); float* rs = rc + 4096 * 32;
      for (int i = bx * NTHR + tid; i < 4096 * 32; i += G * NTHR) { const int pos = i >> 5, j = i & 31;
          const float inv = (float)(1.0 / pow(10000.0, (double)(2 * j) / 64.0)); const float ang = (float)pos * inv;
          rc[i] = (float)cos((double)ang); rs[i] = (float)sin((double)ang); } }
    { bf16* hb = (bf16*)(ws + WS_HB);
      for (size_t i = (size_t)bx * NTHR + tid; i < (size_t)MTOK * DM / 8; i += (size_t)G * NTHR) {
          const f32x4 v0 = *(const f32x4*)(a.x + i * 8), v1 = *(const f32x4*)(a.x + i * 8 + 4);
          u32x4 w; w.x = cvtpk(v0[0], v0[1]); w.y = cvtpk(v0[2], v0[3]); w.z = cvtpk(v1[0], v1[1]); w.w = cvtpk(v1[2], v1[3]);
          *(u32x4*)(hb + i * 8) = w; } }
    LAS float* t = (LAS float*)lds;
    constexpr int I1 = 16 * 88, I2 = 44 * 16, I3 = 16 * 44, I4 = 16 * 16, NIT = 4 * I1 + 4 * I2 + 2 * I3 + 2 * I4;
    for (int it = bx; it < NIT; it += G) {
        int r = it;
        if (r < 4 * I1) { const int mi = r / I1, q = r % I1; transpose_item(a.ffn_w_in + (size_t)mi * 1024 * 5632, 1024, 5632, (bf16*)(ws + WS_W1T) + (size_t)mi * 5632 * 1024, 1, q / 88, q % 88, t, tid); continue; }
        r -= 4 * I1;
        if (r < 4 * I2) { const int mi = r / I2, q = r % I2; transpose_item(a.ffn_w_out + (size_t)mi * DFF * 1024, DFF, 1024, (bf16*)(ws + WS_W2T) + (size_t)mi * 1024 * DFF, 0, q / 16, q % 16, t, tid); continue; }
        r -= 4 * I2;
        if (r < 2 * I3) { const int mi = r / I3, q = r % I3; transpose_item(a.w_in + (size_t)mi * 1024 * INCOLS, 1024, INCOLS, (bf16*)(ws + WS_WINT) + (size_t)mi * NPROJ * 1024, 2, q / 44, q % 44, t, tid); continue; }
        r -= 2 * I3;
        { const int mi = r / I4, q = r % I4; transpose_item(a.w_o + (size_t)mi * 1024 * 1024, 1024, 1024, (bf16*)(ws + WS_WOT) + (size_t)mi * 1024 * 1024, 0, q / 16, q % 16, t, tid); }
    }
}

__device__ __forceinline__ void ln_phase(float* Y, bf16* HB, const float* __restrict__ g, const float* __restrict__ bt, bool fgate, const float* __restrict__ w_in_l,
                                         const float* __restrict__ fbias, float* lgf, LAS unsigned char* lds) {
    int tid_ = threadIdx.x; asm volatile("" : "+v"(tid_));
    const int tid = tid_, lane = tid & 63, wid = tid >> 6, G = gridDim.x;
    LAS f32x4* wf = (LAS f32x4*)lds;
    if (fgate) { for (int k = tid; k < 1024; k += NTHR) wf[k] = *(const f32x4*)(w_in_l + (size_t)k * INCOLS + 1280); }
    __syncthreads();
    f32x4 gv[4], bv[4];
#pragma unroll
    for (int j = 0; j < 4; ++j) { gv[j] = *(const f32x4*)(g + 256 * j + 4 * lane); bv[j] = *(const f32x4*)(bt + 256 * j + 4 * lane); }
    for (int row = blockIdx.x * 8 + wid; row < MTOK; row += G * 8) {
        float* yr = Y + (size_t)row * DM;
        f32x4 v[4]; float s = 0.f;
#pragma unroll
        for (int j = 0; j < 4; ++j) { v[j] = *(const f32x4*)(yr + 256 * j + 4 * lane); s += (v[j][0] + v[j][1]) + (v[j][2] + v[j][3]); }
        const float mean = wave_sum(s) * (1.f / DM); float s2 = 0.f;
#pragma unroll
        for (int j = 0; j < 4; ++j) { v[j] = v[j] - mean; s2 += (v[j][0] * v[j][0] + v[j][1] * v[j][1]) + (v[j][2] * v[j][2] + v[j][3] * v[j][3]); }
        const float rstd = 1.0f / sqrtf(wave_sum(s2) * (1.f / DM) + LN_EPS);
        f32x4 z = {0.f, 0.f, 0.f, 0.f};
#pragma unroll
        for (int j = 0; j < 4; ++j) {
            f32x4 o;
#pragma unroll
            for (int e = 0; e < 4; ++e) o[e] = v[j][e] * rstd * gv[j][e] + bv[j][e];
            *(f32x4*)(yr + 256 * j + 4 * lane) = o;
            u32x2 w; w.x = cvtpk(o[0], o[1]); w.y = cvtpk(o[2], o[3]);
            *(u32x2*)(HB + (size_t)row * DM + 256 * j + 4 * lane) = w;
            if (fgate) {
#pragma unroll
                for (int e = 0; e < 4; ++e) { const f32x4 wv = wf[256 * j + 4 * lane + e]; z = z + wv * o[e]; }
            }
        }
        if (fgate) {
            z[0] = wave_sum(z[0]); z[1] = wave_sum(z[1]); z[2] = wave_sum(z[2]); z[3] = wave_sum(z[3]);
            if (lane < 4) { const float zz = (lane == 0 ? z[0] : lane == 1 ? z[1] : lane == 2 ? z[2] : z[3]) + fbias[lane];
                const float ls = fminf(zz, 0.f) - log1pf(expf(-fabsf(zz)));
                lgf[(size_t)(((row >> 12) * 4 + lane)) * 4096 + (row & 4095)] = ls; }
        }
    }
    __syncthreads();
}

#define MFMA32(a, b, c) __builtin_amdgcn_mfma_f32_32x32x16_bf16((a), (b), (c), 0, 0, 0)
__device__ __forceinline__ bf16x8 pack8(const f32x16& x, int s) {
    u32x4 p; p.x = cvtpk(x[8 * s + 0], x[8 * s + 1]); p.y = cvtpk(x[8 * s + 2], x[8 * s + 3]); p.z = cvtpk(x[8 * s + 4], x[8 * s + 5]); p.w = cvtpk(x[8 * s + 6], x[8 * s + 7]);
    return __builtin_bit_cast(bf16x8, p);
}
__device__ __forceinline__ float ex2(float x) { return __builtin_amdgcn_exp2f(x); }
#define PAIR(v, p) ((f32x2_t){(v)[2 * (p)], (v)[2 * (p) + 1]})
__device__ __forceinline__ void softmax_step(f32x16& st, f32x16& o0, f32x16& o1, float& m_run, float& l_run) {
    float mx = fmaxf(fmaxf(st[0], st[1]), fmaxf(st[2], st[3]));
#pragma unroll
    for (int i = 4; i < 16; i += 2) mx = fmaxf(mx, fmaxf(st[i], st[i + 1]));
    mx = fmaxf(mx, __shfl_xor(mx, 32));
    const float m_new = fmaxf(m_run, mx);
    if (__any(m_new > m_run)) {
        const float al = ex2(m_run - m_new);
        const f32x2_t al2 = {al, al};
#pragma unroll
        for (int p = 0; p < 8; ++p) {
            const f32x2_t a = PAIR(o0, p) * al2, c = PAIR(o1, p) * al2;
            o0[2 * p] = a[0]; o0[2 * p + 1] = a[1]; o1[2 * p] = c[0]; o1[2 * p + 1] = c[1];
        }
        l_run *= al; m_run = m_new;
    }
    const f32x2_t mm = {m_run, m_run};
    f32x2_t ps = {0.f, 0.f};
#pragma unroll
    for (int p = 0; p < 8; ++p) {
        const f32x2_t d = PAIR(st, p) - mm;
        f32x2_t e; e[0] = ex2(d[0]); e[1] = ex2(d[1]);
        ps = ps + e; st[2 * p] = e[0]; st[2 * p + 1] = e[1];
    }
    l_run += ps[0] + ps[1];
}

constexpr int FK_OFF = 0, FV_OFF = 18432, FCUM_OFF = 36864, FSCR_OFF = 53248, KV_PITCH = 144;

template <bool DIAG>
__device__ __forceinline__ void fox_tile(LAS unsigned char* Kb, LAS unsigned char* Vb, const LAS float* cumk, const bf16x8 (&qf)[4], float cq2, int kbase, int qrow, int r, int h,
                                         f32x16& o0, f32x16& o1, float& m_run, float& l_run) {
    f32x16 st0, st1;
#pragma unroll
    for (int i = 0; i < 16; ++i) { st0[i] = 0.f; st1[i] = 0.f; }
#pragma unroll
    for (int ks = 0; ks < 4; ++ks) {
        const bf16x8 a0 = *(const LAS bf16x8*)(Kb + r * KV_PITCH + (16 * ks + 8 * h) * 2);
        const bf16x8 a1 = *(const LAS bf16x8*)(Kb + (32 + r) * KV_PITCH + (16 * ks + 8 * h) * 2);
        st0 = MFMA32(a0, qf[ks], st0); st1 = MFMA32(a1, qf[ks], st1);
    }
    const float C1 = 0.125f * LOG2E;
    const f32x2_t c1v = {C1, C1}, cqv = {cq2, cq2};
#pragma unroll
    for (int gq = 0; gq < 4; ++gq) {
        const f32x4 c0 = *(const LAS f32x4*)(cumk + 8 * gq + 4 * h), c1 = *(const LAS f32x4*)(cumk + 32 + 8 * gq + 4 * h);
#pragma unroll
        for (int pp = 0; pp < 2; ++pp) {
            const int p = 2 * gq + pp;
            const f32x2_t b0 = cqv - (f32x2_t){c0[2 * pp], c0[2 * pp + 1]}, b1 = cqv - (f32x2_t){c1[2 * pp], c1[2 * pp + 1]};
            f32x2_t x0 = PAIR(st0, p) * c1v + b0, x1 = PAIR(st1, p) * c1v + b1;
            if (DIAG) {
                const int key0 = kbase + 8 * gq + 4 * h + 2 * pp;
                if (key0 > qrow) x0[0] = -INFINITY; if (key0 + 1 > qrow) x0[1] = -INFINITY;
                if (key0 + 32 > qrow) x1[0] = -INFINITY; if (key0 + 33 > qrow) x1[1] = -INFINITY;
            }
            st0[2 * p] = x0[0]; st0[2 * p + 1] = x0[1]; st1[2 * p] = x1[0]; st1[2 * p + 1] = x1[1];
        }
    }
    {
        float mx = fmaxf(fmaxf(st0[0], st0[1]), fmaxf(st1[0], st1[1]));
#pragma unroll
        for (int i = 2; i < 16; i += 2) mx = fmaxf(mx, fmaxf(fmaxf(st0[i], st0[i + 1]), fmaxf(st1[i], st1[i + 1])));
        mx = fmaxf(mx, __shfl_xor(mx, 32));
        const float m_new = fmaxf(m_run, mx);
        if (__any(m_new > m_run)) {
            const float al = ex2(m_run - m_new);
            const f32x2_t al2 = {al, al};
#pragma unroll
            for (int p = 0; p < 8; ++p) {
                const f32x2_t a = PAIR(o0, p) * al2, c = PAIR(o1, p) * al2;
                o0[2 * p] = a[0]; o0[2 * p + 1] = a[1]; o1[2 * p] = c[0]; o1[2 * p + 1] = c[1];
            }
            l_run *= al; m_run = m_new;
        }
        const f32x2_t mm = {m_run, m_run};
        f32x2_t ps = {0.f, 0.f};
#pragma unroll
        for (int p = 0; p < 8; ++p) {
            const f32x2_t d0 = PAIR(st0, p) - mm, d1 = PAIR(st1, p) - mm;
            f32x2_t e0, e1; e0[0] = ex2(d0[0]); e0[1] = ex2(d0[1]); e1[0] = ex2(d1[0]); e1[1] = ex2(d1[1]);
            ps = ps + e0; ps = ps + e1;
            st0[2 * p] = e0[0]; st0[2 * p + 1] = e0[1]; st1[2 * p] = e1[0]; st1[2 * p + 1] = e1[1];
        }
        l_run += ps[0] + ps[1];
    }
#pragma unroll
    for (int s2 = 0; s2 < 2; ++s2) {
        const bf16x8 p0 = pack8(st0, s2), p1 = pack8(st1, s2);
#pragma unroll
        for (int ds = 0; ds < 2; ++ds) {
            const LAS unsigned char* vr = Vb + (32 * ds + r) * KV_PITCH;
            const s16x4 lo0 = *(const LAS s16x4*)(vr + (16 * s2 + 4 * h) * 2), hi0 = *(const LAS s16x4*)(vr + (16 * s2 + 8 + 4 * h) * 2);
            const s16x4 lo1 = *(const LAS s16x4*)(vr + (32 + 16 * s2 + 4 * h) * 2), hi1 = *(const LAS s16x4*)(vr + (32 + 16 * s2 + 8 + 4 * h) * 2);
            const bf16x8 va0 = __builtin_shufflevector(lo0, hi0, 0, 1, 2, 3, 4, 5, 6, 7), va1 = __builtin_shufflevector(lo1, hi1, 0, 1, 2, 3, 4, 5, 6, 7);
            if (ds == 0) { o0 = MFMA32(va0, p0, o0); o0 = MFMA32(va1, p1, o0); } else { o1 = MFMA32(va0, p0, o1); o1 = MFMA32(va1, p1, o1); }
        }
    }
}

__device__ __forceinline__ void fox_unit(LAS unsigned char* lds, int b, int head, int qb, const bf16* __restrict__ BQ, const bf16* __restrict__ BK, const bf16* __restrict__ BVT,
                                         const float* __restrict__ lgf, bf16* YCAT) {
    int tid_ = threadIdx.x; asm volatile("" : "+v"(tid_));
    const int tid = tid_, lane = tid & 63, wid = tid >> 6, r = lane & 31, h = lane >> 5;
    const int q0 = qb * 256, kend = q0 + 256, ntiles = kend / 64, bh = b * 4 + head;
    LAS float* cum = (LAS float*)(lds + FCUM_OFF); LAS float* scr = (LAS float*)(lds + FSCR_OFF);
    {
        const float* lf = lgf + (size_t)bh * 4096;
        float v[8];
        if (8 * tid < kend) { const f32x4 a0 = *(const f32x4*)(lf + 8 * tid), a1 = *(const f32x4*)(lf + 8 * tid + 4); v[0] = a0[0]; v[1] = a0[1]; v[2] = a0[2]; v[3] = a0[3]; v[4] = a1[0]; v[5] = a1[1]; v[6] = a1[2]; v[7] = a1[3]; }
        else {
#pragma unroll
            for (int j = 0; j < 8; ++j) v[j] = 0.f; }
#pragma unroll
        for (int j = 1; j < 8; ++j) v[j] += v[j - 1];
        const float total = v[7]; float t = total;
#pragma unroll
        for (int o = 1; o < 64; o <<= 1) { const float n = __shfl_up(t, o); if (lane >= o) t += n; }
        if (lane == 63) scr[wid] = t;
        __syncthreads();
        float woff = 0.f;
        for (int w = 0; w < wid; ++w) woff += scr[w];
        const float base = woff + t - total;
#pragma unroll
        for (int j = 0; j < 8; ++j) cum[8 * tid + j] = (base + v[j]) * LOG2E;
    }
    __syncthreads();
    const int qrow = q0 + 32 * wid + r;
    bf16x8 qf[4];
    { const bf16* qp = BQ + ((size_t)bh * 4096 + qrow) * 64 + 8 * h;
#pragma unroll
      for (int ks = 0; ks < 4; ++ks) qf[ks] = *(const bf16x8*)(qp + 16 * ks); }
    const float cq2 = cum[qrow];
    const int my_last = (q0 + 32 * wid + 31) >> 6;
    f32x16 o0, o1;
#pragma unroll
    for (int i = 0; i < 16; ++i) { o0[i] = 0.f; o1[i] = 0.f; }
    float m_run = -INFINITY, l_run = 0.f;
    const int srow = tid >> 3, sch = tid & 7;
    const bf16* kg = BK + ((size_t)bh * 4096 + srow) * 64 + sch * 8;
    const bf16* vg = BVT + ((size_t)bh * 64 + srow) * 4096 + sch * 8;
    const int soff = srow * KV_PITCH + sch * 16;
    u32x4 kreg = *(const u32x4*)(kg + (size_t)(ntiles - 1) * 4096), vreg = *(const u32x4*)(vg + (ntiles - 1) * 64);
    *(LAS u32x4*)(lds + FK_OFF + soff) = kreg; *(LAS u32x4*)(lds + FV_OFF + soff) = vreg;
    __syncthreads();
    int buf = 0;
    for (int kt = ntiles - 1; kt >= 0; --kt) {
        if (kt > 0) { kreg = *(const u32x4*)(kg + (size_t)(kt - 1) * 4096); vreg = *(const u32x4*)(vg + (kt - 1) * 64); }
        if (kt <= my_last) {
            LAS unsigned char* Kb = lds + FK_OFF + buf * 9216; LAS unsigned char* Vb = lds + FV_OFF + buf * 9216;
            const int kbase = kt * 64;
            if ((kbase + 63) > (q0 + 32 * wid)) fox_tile<true>(Kb, Vb, cum + kbase, qf, cq2, kbase, qrow, r, h, o0, o1, m_run, l_run);
            else fox_tile<false>(Kb, Vb, cum + kbase, qf, cq2, kbase, qrow, r, h, o0, o1, m_run, l_run);
        }
        if (kt > 0) { *(LAS u32x4*)(lds + FK_OFF + (buf ^ 1) * 9216 + soff) = kreg; *(LAS u32x4*)(lds + FV_OFF + (buf ^ 1) * 9216 + soff) = vreg; }
        __syncthreads();
        buf ^= 1;
    }
    const float lt = l_run + __shfl_xor(l_run, 32), inv = 1.0f / lt;
    bf16* yo = YCAT + ((size_t)(b * 4096 + qrow)) * DM + 256 + head * 64 + 4 * h;
#pragma unroll
    for (int gq = 0; gq < 4; ++gq) {
        u32x2 w0, w1;
        w0.x = cvtpk(o0[4 * gq] * inv, o0[4 * gq + 1] * inv); w0.y = cvtpk(o0[4 * gq + 2] * inv, o0[4 * gq + 3] * inv);
        w1.x = cvtpk(o1[4 * gq] * inv, o1[4 * gq + 1] * inv); w1.y = cvtpk(o1[4 * gq + 2] * inv, o1[4 * gq + 3] * inv);
        *(u32x2*)(yo + 8 * gq) = w0; *(u32x2*)(yo + 32 + 8 * gq) = w1;
    }
}

constexpr int DO_OFF = 0, DM_OFF = 131072, DL_OFF = 133120;
__device__ __forceinline__ int dswz(int p) { return (p & ~31) | ((p ^ (p >> 4)) & 31); }

struct DilFrag { bf16x8 ka[4]; bf16x8 va[2][2]; };
__device__ __forceinline__ void dil_load(DilFrag& f, const bf16* __restrict__ CKh, const bf16* __restrict__ VT, int msk, int lgd, int res, int nsubidx, int r, int h) {
    int pos = ((msk + r) << lgd) + res; pos = pos < 0 ? 0 : (pos > 4095 ? 4095 : pos);
    const bf16* kp = CKh + (size_t)pos * 64 + 8 * h;
#pragma unroll
    for (int ks = 0; ks < 4; ++ks) f.ka[ks] = *(const bf16x8*)(kp + 16 * ks);
#pragma unroll
    for (int s2 = 0; s2 < 2; ++s2) {
        int c0 = msk + 16 * s2 + 4 * h, c1 = c0 + 8;
        c0 = (c0 < 0 || c0 >= nsubidx) ? 0 : c0; c1 = (c1 < 0 || c1 >= nsubidx) ? 0 : c1;
#pragma unroll
        for (int ds = 0; ds < 2; ++ds) {
            const bf16* vp = VT + (size_t)(32 * ds + r) * 4096;
            const s16x4 lo = *(const s16x4*)(vp + c0), hi = *(const s16x4*)(vp + c1);
            f.va[s2][ds] = __builtin_shufflevector(lo, hi, 0, 1, 2, 3, 4, 5, 6, 7);
        }
    }
}
template <int MODE>
__device__ __forceinline__ void dil_tile(const DilFrag& f, const bf16x8 (&qf)[4], int r, int h, f32x16& o0, f32x16& o1, float& m_run, float& l_run) {
    f32x16 st;
#pragma unroll
    for (int i = 0; i < 16; ++i) st[i] = 0.f;
#pragma unroll
    for (int ks = 0; ks < 4; ++ks) st = MFMA32(f.ka[ks], qf[ks], st);
    if (MODE != 0) {
#pragma unroll
        for (int i = 0; i < 16; ++i) {
            const int cr = (i & 3) + 8 * (i >> 2) + 4 * h;
            const bool valid = (MODE == 1) ? (cr <= r) : (cr >= r);
            st[i] = valid ? st[i] : -INFINITY;
        }
    }
    softmax_step(st, o0, o1, m_run, l_run);
#pragma unroll
    for (int s2 = 0; s2 < 2; ++s2) {
        const bf16x8 p = pack8(st, s2);
        o0 = MFMA32(f.va[s2][0], p, o0); o1 = MFMA32(f.va[s2][1], p, o1);
    }
}

__device__ __forceinline__ void dil_unit(LAS unsigned char* lds, int b, int head, int blk, const bf16* __restrict__ CQ, const bf16* __restrict__ CK, const bf16* __restrict__ CVT1,
                                         const bf16* __restrict__ CVT4, const bf16* __restrict__ CVT16, bf16* YCAT) {
    int tid_ = threadIdx.x; asm volatile("" : "+v"(tid_));
    const int tid = tid_, lane = tid & 63, wid = tid >> 6, r = lane & 31, h = lane >> 5;
    const int t0 = blk * 512, bh = b * 8 + head;
    LAS float* OL = (LAS float*)(lds + DO_OFF); LAS float* ML = (LAS float*)(lds + DM_OFF); LAS float* LL = (LAS float*)(lds + DL_OFF);
    const bf16* CKh = CK + (size_t)bh * 4096 * 64;
    for (int bi = 0; bi < 3; ++bi) {
        const int lgd = 4 - 2 * bi, d = 1 << lgd, nsubidx = 4096 >> lgd;
        const bf16* VTb = (bi == 0 ? CVT16 : bi == 1 ? CVT4 : CVT1) + (size_t)bh * 64 * 4096;
        for (int gi = 0; gi < 2; ++gi) {
            const int g = 2 * wid + gi, res = g & (d - 1), mb = g >> lgd;
            const int mq0 = (t0 >> lgd) + 32 * mb, ms0 = mq0 - 128;
            const int pos = ((mq0 + r) << lgd) + res, posl = pos - t0;
            const bf16* VT = VTb + (size_t)res * nsubidx;
            bf16x8 qf[4];
            { const bf16* qp = CQ + ((size_t)bh * 4096 + pos) * 64 + 8 * h;
#pragma unroll
              for (int ks = 0; ks < 4; ++ks) qf[ks] = *(const bf16x8*)(qp + 16 * ks); }
            f32x16 o0, o1;
#pragma unroll
            for (int i = 0; i < 16; ++i) { o0[i] = 0.f; o1[i] = 0.f; }
            float m_run = -INFINITY, l_run = 0.f;
            DilFrag fa, fb;
            dil_load(fa, CKh, VT, ms0 + 128, lgd, res, nsubidx, r, h);
            dil_load(fb, CKh, VT, ms0 + 96, lgd, res, nsubidx, r, h);
            dil_tile<1>(fa, qf, r, h, o0, o1, m_run, l_run);
            dil_load(fa, CKh, VT, ms0 + 64, lgd, res, nsubidx, r, h);
            if (ms0 + 96 >= 0) dil_tile<0>(fb, qf, r, h, o0, o1, m_run, l_run);
            dil_load(fb, CKh, VT, ms0 + 32, lgd, res, nsubidx, r, h);
            if (ms0 + 64 >= 0) dil_tile<0>(fa, qf, r, h, o0, o1, m_run, l_run);
            dil_load(fa, CKh, VT, ms0, lgd, res, nsubidx, r, h);
            if (ms0 + 32 >= 0) dil_tile<0>(fb, qf, r, h, o0, o1, m_run, l_run);
            if (ms0 >= 0) dil_tile<2>(fa, qf, r, h, o0, o1, m_run, l_run);
            const float lt = l_run + __shfl_xor(l_run, 32);
            const int sidx = dswz(posl);
            if (bi == 0) {
                ML[posl] = m_run; LL[posl] = lt;
#pragma unroll
                for (int i = 0; i < 16; ++i) { const int dd = (i & 3) + 8 * (i >> 2) + 4 * h; OL[dd * 512 + sidx] = o0[i]; OL[(32 + dd) * 512 + sidx] = o1[i]; }
            } else {
                const float m_old = ML[posl], l_old = LL[posl];
                const float m_new = fmaxf(m_old, m_run), a_old = ex2(m_old - m_new), a_new = ex2(m_run - m_new);
                const float l_new = l_old * a_old + lt * a_new;
                if (bi == 1) {
                    ML[posl] = m_new; LL[posl] = l_new;
#pragma unroll
                    for (int i = 0; i < 16; ++i) { const int dd = (i & 3) + 8 * (i >> 2) + 4 * h;
                        OL[dd * 512 + sidx] = OL[dd * 512 + sidx] * a_old + o0[i] * a_new; OL[(32 + dd) * 512 + sidx] = OL[(32 + dd) * 512 + sidx] * a_old + o1[i] * a_new; }
                } else {
                    const float inv = 1.0f / l_new, s_old = a_old * inv, s_new = a_new * inv;
#pragma unroll
                    for (int i = 0; i < 16; ++i) { const int dd = (i & 3) + 8 * (i >> 2) + 4 * h;
                        o0[i] = OL[dd * 512 + sidx] * s_old + o0[i] * s_new; o1[i] = OL[(32 + dd) * 512 + sidx] * s_old + o1[i] * s_new; }
                    bf16* yo = YCAT + ((size_t)(b * 4096 + pos)) * DM + 512 + head * 64 + 4 * h;
#pragma unroll
                    for (int gq = 0; gq < 4; ++gq) {
                        u32x2 w0, w1;
                        w0.x = cvtpk(o0[4 * gq], o0[4 * gq + 1]); w0.y = cvtpk(o0[4 * gq + 2], o0[4 * gq + 3]);
                        w1.x = cvtpk(o1[4 * gq], o1[4 * gq + 1]); w1.y = cvtpk(o1[4 * gq + 2], o1[4 * gq + 3]);
                        *(u32x2*)(yo + 8 * gq) = w0; *(u32x2*)(yo + 32 + 8 * gq) = w1;
                    }
                }
            }
        }
        __syncthreads();
    }
}

__device__ __forceinline__ void conv_unit(LAS unsigned char* lds, int b, int tile, const bf16* __restrict__ AV, const bf16* __restrict__ AG, const float* __restrict__ cw,
                                          const float* __restrict__ cb, const float* __restrict__ cg_, const float* __restrict__ cbeta, bf16* YCAT) {
    int tid_ = threadIdx.x; asm volatile("" : "+v"(tid_));
    const int tid = tid_, lane = tid & 63, wid = tid >> 6;
    const int t0 = tile * 32;
    LAS float* u = (LAS float*)lds;
    LAS float* co = (LAS float*)(lds + 63488);
    for (int c = tid; c < 62 * 32; c += NTHR) {
        const int tt = c >> 5, ch = (c & 31) * 8, t = t0 - 30 + tt;
        float uv[8];
        if (t >= 0) {
            const size_t off = ((size_t)(b * 4096 + t)) * 256 + ch;
            const u32x4 vv = *(const u32x4*)(AV + off), gg = *(const u32x4*)(AG + off);
#pragma unroll
            for (int j = 0; j < 4; ++j) {
                const unsigned vw = vv[j], gw = gg[j];
                const float v0 = __builtin_bit_cast(float, vw << 16), v1 = __builtin_bit_cast(float, vw & 0xffff0000u);
                const float g0 = __builtin_bit_cast(float, gw << 16), g1 = __builtin_bit_cast(float, gw & 0xffff0000u);
                uv[2 * j] = v0 * sigmoid_f(g0); uv[2 * j + 1] = v1 * sigmoid_f(g1);
            }
        } else {
#pragma unroll
            for (int j = 0; j < 8; ++j) uv[j] = 0.f;
        }
        *(LAS f32x4*)(u + tt * 256 + ch) = (f32x4){uv[0], uv[1], uv[2], uv[3]};
        *(LAS f32x4*)(u + tt * 256 + ch + 4) = (f32x4){uv[4], uv[5], uv[6], uv[7]};
    }
    const int ch = tid & 255, half = tid >> 8;
    float w[31];
#pragma unroll
    for (int k = 0; k < 31; ++k) w[k] = cw[k * 256 + ch];
    const float bias = cb[ch];
    __syncthreads();
    for (int j = 0; j < 16; ++j) {
        const int tl = half * 16 + j;
        float acc = bias;
#pragma unroll
        for (int k = 0; k < 31; ++k) acc += w[k] * u[(tl + k) * 256 + ch];
        co[tl * 256 + ch] = acc;
    }
    __syncthreads();
    const f32x4 gv = *(const f32x4*)(cg_ + 4 * lane), bv = *(const f32x4*)(cbeta + 4 * lane);
#pragma unroll
    for (int j = 0; j < 4; ++j) {
        const int tl = wid * 4 + j;
        f32x4 v = *(const LAS f32x4*)(co + tl * 256 + 4 * lane);
        const float mean = wave_sum((v[0] + v[1]) + (v[2] + v[3])) * (1.f / 256.f);
        v = v - mean;
        const float var = wave_sum((v[0] * v[0] + v[1] * v[1]) + (v[2] * v[2] + v[3] * v[3])) * (1.f / 256.f);
        const float rstd = 1.0f / sqrtf(var + LN_EPS);
        float o[4];
#pragma unroll
        for (int e = 0; e < 4; ++e) o[e] = silu_f(v[e] * rstd * gv[e] + bv[e]);
        u32x2 wv; wv.x = cvtpk(o[0], o[1]); wv.y = cvtpk(o[2], o[3]);
        *(u32x2*)(YCAT + ((size_t)(b * 4096 + t0 + tl)) * DM + 4 * lane) = wv;
    }
    __syncthreads();
}

#define XB_TMO      128
#define XB_XCNT(j)  (256  + 64 * (j))
#define XB_XSUB(j)  (1280 + 64 * (j))
#define XB_XGEN(j)  (2304 + 64 * (j))
#define XB_TOP      3328
#define XB_TOPGEN   3392
#define XCD_BAR_WORDS 3456
#define XB_SPIN_CAP (1u << 18)

__device__ __forceinline__ unsigned xb_ld(unsigned* p)              { return __hip_atomic_load(p, __ATOMIC_RELAXED, __HIP_MEMORY_SCOPE_AGENT); }
__device__ __forceinline__ unsigned xb_add(unsigned* p, unsigned v) { return __hip_atomic_fetch_add(p, v, __ATOMIC_RELAXED, __HIP_MEMORY_SCOPE_AGENT); }
__device__ __forceinline__ unsigned xb_xcc_id() { return (unsigned)__builtin_amdgcn_s_getreg((3 << 11) | 20) & 0xFu; }
#define XB_SPIN(cond, bar) do { unsigned _sp = 0; while (cond) { __builtin_amdgcn_s_sleep(1); \
    if ((++_sp & 255u) == 0u) { if (xb_ld(&(bar)[XB_TMO])) break; if (_sp > XB_SPIN_CAP) { atomicAdd(&(bar)[XB_TMO], 1u); break; } } } } while (0)

struct XcdBarrier {
    unsigned* bar; unsigned x;
    volatile LAS unsigned* st;
};

__device__ __forceinline__ XcdBarrier xcd_barrier_post(unsigned* bar, volatile LAS unsigned* st) {
    XcdBarrier b; b.bar = bar; b.x = xb_xcc_id(); b.st = st;
    if (threadIdx.x == 0) (void)xb_add(&bar[XB_XCNT(b.x)], 1u);
    return b;
}
__device__ __forceinline__ void xcd_barrier_complete(unsigned* bar, unsigned x, unsigned& nloc, unsigned& nx) {
    const unsigned G = gridDim.x * gridDim.y * gridDim.z;
    unsigned sum, cnt, mine, sp = 0u;
    for (;;) {
        sum = 0u; cnt = 0u; mine = 0u;
#pragma unroll
        for (unsigned j = 0; j < 16; ++j) { const unsigned c = xb_ld(&bar[XB_XCNT(j)]); sum += c; cnt += (c > 0u) ? 1u : 0u; mine = (j == x) ? c : mine; }
        if (sum == G) break;
        __builtin_amdgcn_s_sleep(1);
        if ((++sp & 255u) == 0u) { if (xb_ld(&bar[XB_TMO])) break; if (sp > XB_SPIN_CAP) { atomicAdd(&bar[XB_TMO], 1u); break; } }
    }
    nloc = mine > 0u ? mine : 1u; nx = cnt > 0u ? cnt : 1u;
}

__device__ __forceinline__ void xcd_barrier(const XcdBarrier& b) {
    asm volatile("s_waitcnt vmcnt(0)" ::: "memory");
    __syncthreads();
    if (threadIdx.x == 0) {
        unsigned* bar = b.bar;
        __builtin_amdgcn_s_waitcnt(0);
        unsigned nloc = b.st[0], nx = b.st[1];
        if (nloc == 0u) { xcd_barrier_complete(bar, b.x, nloc, nx); b.st[0] = nloc; b.st[1] = nx; }
        const unsigned old = xb_add(&bar[XB_XSUB(b.x)], 1u);
        const unsigned gen = old / nloc;
        if (old + 1u == (gen + 1u) * nloc) {
            __builtin_amdgcn_fence(__ATOMIC_RELEASE, "agent");
            asm volatile("s_waitcnt vmcnt(0)" ::: "memory");
            const unsigned og = xb_add(&bar[XB_TOP], 1u);
            const unsigned tg = og / nx;
            if (og + 1u == (tg + 1u) * nx) xb_add(&bar[XB_TOPGEN], 1u);
            else XB_SPIN(xb_ld(&bar[XB_TOPGEN]) == tg, bar);
            __builtin_amdgcn_fence(__ATOMIC_ACQUIRE, "agent");
            xb_add(&bar[XB_XGEN(b.x)], 1u);
            asm volatile("s_waitcnt vmcnt(0)" ::: "memory");
        } else {
            XB_SPIN(xb_ld(&bar[XB_XGEN(b.x)]) == gen, bar);
            __builtin_amdgcn_fence(__ATOMIC_ACQUIRE, "agent");
            asm volatile("s_waitcnt vmcnt(0)" ::: "memory");
        }
    }
    __syncthreads();
}

#ifndef SYNC_REPS
#define SYNC_REPS 1
#endif
#ifndef MIX_REPS
#define MIX_REPS 1
#endif
#ifndef MIX2_LO
#define MIX2_LO 0
#endif
#ifndef MIX2_HI
#define MIX2_HI 1024
#endif
#ifndef G1_REPS
#define G1_REPS 1
#endif
#ifndef G3_REPS
#define G3_REPS 1
#endif
#ifndef PRO_REPS
#define PRO_REPS 1
#endif
#define GSYNC() do { for (int r_ = 0; r_ < SYNC_REPS; ++r_) xcd_barrier(xbar); } while (0)
__global__ void __launch_bounds__(NTHR, 2) hybrid_fwd(Args a) {
    extern __shared__ __attribute__((aligned(16))) unsigned char lds_raw[];
    LAS unsigned char* lds = (LAS unsigned char*)lds_raw;
    cg::grid_group grid = cg::this_grid();
    const int tid = threadIdx.x, G = gridDim.x, bx = blockIdx.x;
    unsigned char* ws = a.ws;
    bf16* HB = (bf16*)(ws + WS_HB); bf16* ACT = (bf16*)(ws + WS_ACT); bf16* YCAT = (bf16*)(ws + WS_YCAT);
    bf16 *AV = (bf16*)(ws + WS_AV), *AG = (bf16*)(ws + WS_AG), *BQ = (bf16*)(ws + WS_BQ), *BK = (bf16*)(ws + WS_BK), *BVT = (bf16*)(ws + WS_BVT), *CQ = (bf16*)(ws + WS_CQ), *CK = (bf16*)(ws + WS_CK),
         *CVT1 = (bf16*)(ws + WS_CVT1), *CVT4 = (bf16*)(ws + WS_CVT4), *CVT16 = (bf16*)(ws + WS_CVT16);
    float* lgf = (float*)(ws + WS_LGF); const float* rope = (const float*)(ws + WS_ROPE);
    unsigned* ctl = (unsigned*)(ws + WS_CTL);
    float* H = a.out;

    if (tid < 2) ((volatile LAS unsigned*)(lds + LDS_MISC + 64))[tid] = 0u;
    for (int r_ = 0; r_ < PRO_REPS; ++r_) prologue(a, lds);
    grid.sync();
    XcdBarrier xbar = xcd_barrier_post(ctl + CW_BAR, (volatile LAS unsigned*)(lds + LDS_MISC + 64));

    for (int l = 0; l < 2; ++l) {
        for (int j = 0; j < 3; ++j) {
            if (j != 1) {
                const int fi = l * 2 + (j >> 1);
                {
                    pg8::Gemm g{HB, (const bf16*)(ws + WS_W1T) + (size_t)fi * 5632 * 1024, MTOK, 2 * DFF, DM};
                    pg8::StaticOrder S; S.init(MTOK, 2 * DFF, G, bx);
                    EpiSwiGLU E{ACT};
                    for (int r_ = 0; r_ < G1_REPS; ++r_) pg8::gemm_phase<EpiSwiGLU, pg8::StaticOrder, true, true>(lds, g, S, E);
                }
                GSYNC();
                {
                    pg8::Gemm g{ACT, (const bf16*)(ws + WS_W2T) + (size_t)fi * 1024 * DFF, MTOK, DM, DFF};
                    pg8::StaticOrder S; S.init(MTOK, DM, G, bx);
                    EpiResid E{(l == 0 && j == 0) ? a.x : (const float*)H, H, 0.5f};
#ifndef NO_G2
                    pg8::gemm_phase<EpiResid, pg8::StaticOrder, true, true>(lds, g, S, E);
#endif
                }
                GSYNC();
            } else {
                {
                    pg8::Gemm g{HB, (const bf16*)(ws + WS_WINT) + (size_t)l * NPROJ * 1024, MTOK, NPROJ, DM};
                    pg8::StaticOrder S; S.init(MTOK, NPROJ, G, bx);
                    EpiProj E{AV, AG, BQ, BK, BVT, CQ, CK, CVT1, CVT4, CVT16, rope};
                    for (int r_ = 0; r_ < G3_REPS; ++r_) pg8::gemm_phase<EpiProj, pg8::StaticOrder, true, true>(lds, g, S, E);
                }
                GSYNC();
                {
                    LAS int* itemw = (LAS int*)(lds + LDS_MISC);
                    for (int rep = 0; rep < MIX_REPS; ++rep) {
                    const int lo = rep == 0 ? 0 : MIX2_LO, hi = rep == 0 ? 1024 : MIX2_HI;
                    if (rep) grid.sync();
                    for (;;) {
                        __syncthreads();
                        if (tid == 0) *itemw = (int)atomicAdd(ctl + l + 8 * rep, 1u) + lo;
                        __syncthreads();
                        const int it = *itemw;
                        if (it >= hi) break;
                        if (it < 256) { const int qb = 15 - (it >> 4), bhh = it & 15;
#ifndef NO_FOX
 fox_unit(lds, bhh >> 2, bhh & 3, qb, BQ, BK, BVT, lgf, YCAT);
#endif
 }
                        else if (it < 512) { const int q = it - 256;
#ifndef NO_DIL
 dil_unit(lds, q >> 6, (q >> 3) & 7, q & 7, CQ, CK, CVT1, CVT4, CVT16, YCAT);
#endif
 }
                        else { const int q = it - 512;
#ifndef NO_CONV
 conv_unit(lds, q >> 7, q & 127, AV, AG, a.conv_w + (size_t)l * 31 * 256, a.conv_b + l * 256, a.conv_g + l * 256, a.conv_beta + l * 256, YCAT);
#endif
 }
                    }
                    }
                }
                GSYNC();
                {
                    pg8::Gemm g{YCAT, (const bf16*)(ws + WS_WOT) + (size_t)l * 1024 * 1024, MTOK, DM, DM};
                    pg8::StaticOrder S; S.init(MTOK, DM, G, bx);
                    EpiResid E{(const float*)H, H, 1.0f};
#ifndef NO_G4
                    pg8::gemm_phase<EpiResid, pg8::StaticOrder, true, true>(lds, g, S, E);
#endif
                }
                GSYNC();
            }
#ifndef NO_LN
            ln_phase(H, HB, a.ln_g + (size_t)(l * 3 + j) * DM, a.ln_b + (size_t)(l * 3 + j) * DM, j == 0, a.w_in + (size_t)l * 1024 * INCOLS, a.fbias + l * 4, lgf, lds);
#endif
            if (!(l == 1 && j == 2)) GSYNC();
        }
    }
}

extern "C" void kernel_launch(void* const* d_in, const int* in_sizes, int n_in, void* d_out, int out_size, void* d_ws, size_t ws_size, hipStream_t stream) {
    static int grid_blocks = 0;
    if (grid_blocks == 0) {
        if (n_in != 12 || out_size != MTOK * DM || ws_size < WS_END) { fprintf(stderr, "kernel_launch: unexpected problem (n_in %d out %d ws %zu)\n", n_in, out_size, ws_size); grid_blocks = -1; return; }
        int dev = 0, cus = 0, per_cu = 0;
        hipGetDevice(&dev);
        hipDeviceGetAttribute(&cus, hipDeviceAttributeMultiprocessorCount, dev);
        if (hipFuncSetAttribute((const void*)hybrid_fwd, hipFuncAttributeMaxDynamicSharedMemorySize, LDS_BYTES) != hipSuccess) { fprintf(stderr, "hipFuncSetAttribute failed\n"); grid_blocks = -1; return; }
        if (hipOccupancyMaxActiveBlocksPerMultiprocessor(&per_cu, (const void*)hybrid_fwd, NTHR, LDS_BYTES) != hipSuccess || per_cu < 1) { fprintf(stderr, "occupancy query failed (%d)\n", per_cu); (void)hipGetLastError(); per_cu = 1; }
        grid_blocks = cus * 1;
    }
    if (grid_blocks < 0) return;
    Args a{};
    a.x = (const float*)d_in[0]; a.w_in = (const float*)d_in[1]; a.w_o = (const float*)d_in[2]; a.fbias = (const float*)d_in[3]; a.conv_w = (const float*)d_in[4]; a.conv_b = (const float*)d_in[5];
    a.conv_g = (const float*)d_in[6]; a.conv_beta = (const float*)d_in[7]; a.ffn_w_in = (const float*)d_in[8]; a.ffn_w_out = (const float*)d_in[9]; a.ln_g = (const float*)d_in[10]; a.ln_b = (const float*)d_in[11];
    a.out = (float*)d_out; a.ws = (unsigned char*)d_ws;
    void* args[] = {&a};
    hipError_t e = hipLaunchCooperativeKernel((const void*)hybrid_fwd, dim3(grid_blocks), dim3(NTHR), args, LDS_BYTES, stream);
    if (e != hipSuccess) fprintf(stderr, "cooperative launch failed: %s (grid %d)\n", hipGetErrorString(e), grid_blocks);
}
```

```cpp
#include <hip/hip_runtime.h>
#include <hip/hip_cooperative_groups.h>
#include <cstdio>
#include <cstdint>
#include <cmath>
namespace cg = cooperative_groups;
namespace pg8 {
#define PG8_LAS __attribute__((address_space(3)))
typedef unsigned short bf16_t;
typedef short bf16x8 __attribute__((ext_vector_type(8)));
typedef float f32x4 __attribute__((ext_vector_type(4)));
typedef unsigned u32x4 __attribute__((ext_vector_type(4)));
constexpr int BM = 256, BK = 64, HALF = 128, HTB = HALF * BK * 2  , STAGE_BYTES = 8 * HTB, NXCD = 8, WGM = 8;

__host__ __device__ __forceinline__ int lds_byte(int r, int c) { const int st = (r >> 4) * 2 + (c >> 5), rr = r & 15, cc = c & 31, ob = rr * 64 + cc * 2; return st * 1024 + (ob ^ (((ob >> 9) & 1) << 5)); }
__host__ __device__ __forceinline__ void stage_rc(int b, int& R, int& C) { const int st = b / 1024, sb = b % 1024, swz = sb ^ (((sb >> 9) & 1) << 5); R = (st >> 1) * 16 + swz / 64; C = (st & 1) * 32 + (swz % 64) / 2; }
__host__ __device__ __forceinline__ int perm32(int rho) { const int n = rho >> 4, i = rho & 15; return 8 * (i >> 2) + 4 * n + (i & 3); }

struct Unit { int pm, pn; };
struct Gemm { const bf16_t* A; const bf16_t* Bt; int M, N, K; };

struct StaticOrder {
    int nM, nN, nwg, G, c;
    __host__ __device__ void init(int M, int N, int G_, int c_) { nM = M / BM; nN = N / BM; nwg = nM * nN; G = G_; c = c_; }
    __host__ __device__ bool next(int i, Unit& u) const {
        const long L = (long)i * G + c; if (L >= nwg) return false;
        int wgid = (int)L; { const int q = nwg / NXCD, r = nwg % NXCD, xcd = wgid % NXCD, off = wgid / NXCD; wgid = (xcd < r ? xcd * (q + 1) : r * (q + 1) + (xcd - r) * q) + off; }
        const int nig = WGM * nN, gid = wgid / nig, fm = gid * WGM, gsz = (nM - fm) < WGM ? (nM - fm) : WGM;
        u.pm = fm + ((wgid % nig) % gsz); u.pn = (wgid % nig) / gsz; return true;
    }
    __device__ __forceinline__ void a_ready(const Unit&) const {}
    __device__ __forceinline__ void done(const Unit&) const {}
};

__device__ __forceinline__ unsigned cvt_pk_bf16(float lo, float hi) { unsigned r; asm volatile("v_cvt_pk_bf16_f32 %0, %1, %2" : "=v"(r) : "v"(lo), "v"(hi)); return r; }
typedef float f32x2 __attribute__((ext_vector_type(2)));
template <class Epi, class Sched, bool ALIGN_EPI = false, bool SP2 = false>
__device__ __forceinline__ void gemm_phase(PG8_LAS unsigned char* lds, const Gemm g, const Sched& S, const Epi& E) {
    int tid_ = threadIdx.x; asm volatile("" : "+v"(tid_));
    const int tid = tid_, wid = __builtin_amdgcn_readfirstlane(tid >> 6), lane = tid & 63, wr = wid >> 2, wc = wid & 3, fr = lane & 15, fq = lane >> 4;
    const int K = g.K, nt = K / BK;
    unsigned voffA[2], voffB[2];
#pragma unroll
    for (int i = 0; i < 2; ++i) { int R, C; stage_rc(tid * 16 + i * 8192, R, C); const int Rb = Epi::PERM ? ((R & ~31) + perm32(R & 31)) : R;
        voffA[i] = (unsigned)(R * K + C) * 2u; voffB[i] = (unsigned)(Rb * K + C) * 2u; }
    const size_t kstep = (size_t)(BK * 2);
    const size_t hstep = (size_t)HALF * K * 2;
    const size_t tstep = 2 * hstep;
    const unsigned ldsw = (unsigned)wid * 1024u;
    const int aoff = lds_byte(wr * 64 + fr, fq * 8), boff = lds_byte(wc * 32 + fr, fq * 8);
#define PG8_SA(b, h) (((b) * 2 + (h)) * HTB)
#define PG8_SB(b, h) ((4 + (b) * 2 + (h)) * HTB)
#define PG8_STAGE(bufoff, gbase, voff) do { _Pragma("unroll") for (int _i = 0; _i < 2; ++_i) \
        __builtin_amdgcn_global_load_lds((const unsigned*)((const char*)(gbase) + (voff)[_i]), (PG8_LAS unsigned*)(lds + (bufoff) + ldsw + _i * 8192), 16, 0, 0); } while (0)
#define PG8_LDA(dst, b, h) do { _Pragma("unroll") for (int m = 0; m < 4; ++m) _Pragma("unroll") for (int k = 0; k < 2; ++k) dst[m][k] = *(const PG8_LAS bf16x8*)(lds + PG8_SA(b, h) + aoff + m * 2048 + k * 1024); } while (0)
#define PG8_LDB(dst, b, h) do { _Pragma("unroll") for (int n = 0; n < 2; ++n) _Pragma("unroll") for (int k = 0; k < 2; ++k) dst[n][k] = *(const PG8_LAS bf16x8*)(lds + PG8_SB(b, h) + boff + n * 2048 + k * 1024); } while (0)
#define PG8_MMA(ai, bj, At, Bt) do { __builtin_amdgcn_s_setprio(1); _Pragma("unroll") for (int m = 0; m < 4; ++m) _Pragma("unroll") for (int n = 0; n < 2; ++n) _Pragma("unroll") for (int k = 0; k < 2; ++k) \
        acc[ai][bj][m][n] = __builtin_amdgcn_mfma_f32_16x16x32_bf16(Bt[n][k], At[m][k], acc[ai][bj][m][n], 0, 0, 0); __builtin_amdgcn_s_setprio(0); } while (0)
#define PG8_WAIT_V(n) asm volatile("s_waitcnt vmcnt(" #n ")" ::: "memory")
#define PG8_WAIT_L(n) asm volatile("s_waitcnt lgkmcnt(" #n ")" ::: "memory")
#define PG8_BAR __builtin_amdgcn_s_barrier()
#define PG8_SCHED __builtin_amdgcn_sched_barrier(0)
    Unit cur, nxt; int ui = 0;
    if (!S.next(0, cur)) return;
    f32x4 acc[2][2][4][2];
#pragma unroll
    for (int a = 0; a < 2; ++a)
#pragma unroll
        for (int b = 0; b < 2; ++b)
#pragma unroll
            for (int m = 0; m < 4; ++m)
#pragma unroll
                for (int n = 0; n < 2; ++n) acc[a][b][m][n] = (f32x4){0.f, 0.f, 0.f, 0.f};
    bf16x8 At[4][2], B0[2][2], B1[2][2];
    const char* cA = (const char*)g.A + (size_t)cur.pm * tstep; const char* cB = (const char*)g.Bt + (size_t)cur.pn * tstep;
    S.a_ready(cur);
    if constexpr (SP2) {
        PG8_STAGE(PG8_SB(0, 0), cB, voffB); PG8_STAGE(PG8_SB(0, 1), cB + hstep, voffB); PG8_STAGE(PG8_SA(0, 0), cA, voffA); PG8_STAGE(PG8_SA(0, 1), cA + hstep, voffA);
        if (wr == 1) PG8_BAR;
        PG8_WAIT_V(2); PG8_BAR;
        PG8_STAGE(PG8_SB(1, 0), cB + kstep, voffB); PG8_STAGE(PG8_SA(1, 0), cA + kstep, voffA); PG8_STAGE(PG8_SB(1, 1), cB + hstep + kstep, voffB);
        PG8_WAIT_V(6); PG8_BAR;
    } else {
        PG8_STAGE(PG8_SB(0, 0), cB, voffB); PG8_STAGE(PG8_SA(0, 0), cA, voffA); PG8_STAGE(PG8_SB(0, 1), cB + hstep, voffB); PG8_STAGE(PG8_SA(0, 1), cA + hstep, voffA);
        if (wr == 1) PG8_BAR;
        PG8_WAIT_V(4); PG8_BAR;
        PG8_STAGE(PG8_SB(1, 0), cB + kstep, voffB); PG8_STAGE(PG8_SA(1, 0), cA + kstep, voffA); PG8_STAGE(PG8_SB(1, 1), cB + hstep + kstep, voffB);
        PG8_WAIT_V(6); PG8_BAR;
    }
    for (;;) {
        const bool has_next = S.next(ui + 1, nxt);
        const char* nA = has_next ? (const char*)g.A + (size_t)nxt.pm * tstep : cA; const char* nB = has_next ? (const char*)g.Bt + (size_t)nxt.pn * tstep : cB;
        for (int t = 0; t < nt; t += 2) {
            const bool last = (t == nt - 2);
            const char* a1 = cA + (size_t)(t + 1) * kstep;
            const char* a2 = last ? nA : cA + (size_t)(t + 2) * kstep; const char* b2 = last ? nB : cB + (size_t)(t + 2) * kstep;
            const char* a3 = a2 + kstep; const char* b3 = b2 + kstep;
            if (last && has_next) S.a_ready(nxt);
            if constexpr (SP2) {
            PG8_LDB(B0, 0, 0); PG8_LDB(B1, 0, 1); PG8_SCHED; PG8_LDA(At, 0, 0); PG8_STAGE(PG8_SA(1, 1), a1 + hstep, voffA);
            PG8_WAIT_V(8); PG8_WAIT_L(0); PG8_BAR; PG8_MMA(0, 0, At, B0); PG8_MMA(0, 1, At, B1); PG8_BAR; PG8_SCHED;
            PG8_LDA(At, 0, 1); PG8_STAGE(PG8_SB(0, 0), b2, voffB); PG8_STAGE(PG8_SB(0, 1), b2 + hstep, voffB); PG8_STAGE(PG8_SA(0, 0), a2, voffA);
            PG8_WAIT_V(8); PG8_WAIT_L(0); PG8_BAR; PG8_MMA(1, 0, At, B0); PG8_MMA(1, 1, At, B1); PG8_BAR; PG8_SCHED;
            PG8_LDB(B0, 1, 0); PG8_LDB(B1, 1, 1); PG8_SCHED; PG8_LDA(At, 1, 0); PG8_STAGE(PG8_SA(0, 1), a2 + hstep, voffA);
            PG8_WAIT_V(8); PG8_WAIT_L(0); PG8_BAR; PG8_MMA(0, 0, At, B0); PG8_MMA(0, 1, At, B1); PG8_BAR; PG8_SCHED;
            PG8_LDA(At, 1, 1); PG8_STAGE(PG8_SB(1, 0), b3, voffB); PG8_STAGE(PG8_SB(1, 1), b3 + hstep, voffB); PG8_STAGE(PG8_SA(1, 0), a3, voffA);
            PG8_WAIT_V(8); PG8_WAIT_L(0); PG8_BAR; PG8_MMA(1, 0, At, B0); PG8_MMA(1, 1, At, B1); PG8_BAR; PG8_SCHED;
            } else {
            PG8_LDB(B0, 0, 0); PG8_SCHED; PG8_LDA(At, 0, 0); PG8_STAGE(PG8_SA(1, 1), a1 + hstep, voffA);
            PG8_WAIT_L(8); PG8_BAR; PG8_WAIT_L(0); PG8_MMA(0, 0, At, B0); PG8_BAR; PG8_SCHED;
            PG8_LDB(B1, 0, 1); PG8_STAGE(PG8_SB(0, 0), b2, voffB);
            PG8_BAR; PG8_WAIT_L(0); PG8_MMA(0, 1, At, B1); PG8_BAR;
            PG8_LDA(At, 0, 1); PG8_STAGE(PG8_SA(0, 0), a2, voffA);
            PG8_BAR; PG8_WAIT_L(0); PG8_MMA(1, 0, At, B0); PG8_BAR; PG8_SCHED;
            PG8_STAGE(PG8_SB(0, 1), b2 + hstep, voffB);
            PG8_WAIT_V(6); PG8_BAR; PG8_MMA(1, 1, At, B1); PG8_BAR;
            PG8_LDB(B0, 1, 0); PG8_SCHED; PG8_LDA(At, 1, 0); PG8_STAGE(PG8_SA(0, 1), a2 + hstep, voffA);
            PG8_WAIT_L(8); PG8_BAR; PG8_WAIT_L(0); PG8_MMA(0, 0, At, B0); PG8_BAR; PG8_SCHED;
            PG8_LDB(B1, 1, 1); PG8_STAGE(PG8_SB(1, 0), b3, voffB);
            PG8_BAR; PG8_WAIT_L(0); PG8_MMA(0, 1, At, B1); PG8_BAR;
            PG8_LDA(At, 1, 1); PG8_STAGE(PG8_SA(1, 0), a3, voffA);
            PG8_BAR; PG8_WAIT_L(0); PG8_MMA(1, 0, At, B0); PG8_BAR; PG8_SCHED;
            PG8_STAGE(PG8_SB(1, 1), b3 + hstep, voffB);
            PG8_WAIT_V(6); PG8_BAR; PG8_MMA(1, 1, At, B1); PG8_BAR;
            }
        }
        if constexpr (ALIGN_EPI) { if (wr == 0) PG8_BAR; }
        if constexpr (!Epi::AFTER_DRAIN) { E(acc, cur, wr, wc, fr, fq); S.done(cur); }
        if (!has_next) break;
#pragma unroll
        for (int a = 0; a < 2; ++a)
#pragma unroll
            for (int b = 0; b < 2; ++b)
#pragma unroll
                for (int m = 0; m < 4; ++m)
#pragma unroll
                    for (int n = 0; n < 2; ++n) acc[a][b][m][n] = (f32x4){0.f, 0.f, 0.f, 0.f};
        cur = nxt; cA = nA; cB = nB; ++ui;
        if constexpr (ALIGN_EPI) { if (wr == 1) PG8_BAR; }
    }
    PG8_WAIT_V(0);
    if constexpr (!ALIGN_EPI) { if (wr == 0) PG8_BAR; }
    PG8_BAR;
    if constexpr (Epi::AFTER_DRAIN) { E.fused(acc, cur, wr, wc, fr, fq, lds, wid, lane); S.done(cur); }
#undef PG8_SA
#undef PG8_SB
#undef PG8_STAGE
#undef PG8_LDA
#undef PG8_LDB
#undef PG8_MMA
#undef PG8_WAIT_V
#undef PG8_WAIT_L
#undef PG8_BAR
#undef PG8_SCHED
}
}

#define LAS __attribute__((address_space(3)))
typedef unsigned short bf16;
typedef short bf16x8 __attribute__((ext_vector_type(8)));
typedef short s16x4 __attribute__((ext_vector_type(4)));
typedef float f32x4 __attribute__((ext_vector_type(4)));
typedef float f32x16 __attribute__((ext_vector_type(16)));
typedef unsigned u32x4 __attribute__((ext_vector_type(4)));
typedef unsigned u32x2 __attribute__((ext_vector_type(2)));
typedef float f32x2_t __attribute__((ext_vector_type(2)));
typedef __bf16 bf16x2_t __attribute__((ext_vector_type(2)));

constexpr int NB = 4, SEQ = 4096, DM = 1024, MTOK = NB * SEQ, DFF = 2816, NPROJ = 2816, INCOLS = 2820;
constexpr float ALPHA = 1.41421356237309515f, LN_EPS = 1e-5f, LOG2E = 1.4426950408889634f;
constexpr size_t MiB = 1u << 20;
constexpr size_t WS_CTL = 0, WS_ROPE = 1 * MiB, WS_W1T = 2 * MiB, WS_W2T = 46 * MiB, WS_WINT = 68 * MiB, WS_WOT = 79 * MiB, WS_HB = 83 * MiB, WS_LGF = 115 * MiB,
                 WS_ACT = 116 * MiB, WS_AV = 116 * MiB, WS_AG = 124 * MiB, WS_BQ = 132 * MiB, WS_BK = 140 * MiB, WS_BVT = 148 * MiB, WS_CQ = 156 * MiB, WS_CK = 172 * MiB,
                 WS_CVT1 = 188 * MiB, WS_CVT4 = 204 * MiB, WS_CVT16 = 220 * MiB, WS_YCAT = 236 * MiB, WS_END = 268 * MiB;
constexpr int LDS_BYTES = 147456, LDS_MISC = 143360;
constexpr int NTHR = 512;
constexpr int CW_BAR = 4096;
#define XCD_BAR_WORDS 3456

__device__ __forceinline__ unsigned cvtpk(float lo, float hi) { f32x2_t v = {lo, hi}; bf16x2_t b = __builtin_convertvector(v, bf16x2_t); return __builtin_bit_cast(unsigned, b); }
__device__ __forceinline__ unsigned short f2bf(float f) { return (unsigned short)(cvtpk(f, 0.f) & 0xffffu); }
__device__ __forceinline__ float bf2f(unsigned short b) { return __builtin_bit_cast(float, (unsigned)b << 16); }
__device__ __forceinline__ float wave_sum(float v) {
#pragma unroll
    for (int o = 1; o < 64; o <<= 1) v += __shfl_xor(v, o);
    return v;
}
__device__ __forceinline__ float silu_f(float g) { return g * __builtin_amdgcn_rcpf(1.f + __expf(-g)); }
__device__ __forceinline__ float sigmoid_f(float g) { return __builtin_amdgcn_rcpf(1.f + __expf(-g)); }

struct EpiSwiGLU {
    static constexpr bool PERM = true, AFTER_DRAIN = false;
    bf16* O;
    __device__ __forceinline__ void operator()(const pg8::f32x4 (&acc)[2][2][4][2], const pg8::Unit& u, int wr, int wc, int fr, int fq) const {
        const int row0 = u.pm * 256 + wr * 64 + fr, col0 = u.pn * 128 + wc * 32 + 8 * fq;
#pragma unroll
        for (int ai = 0; ai < 2; ++ai)
#pragma unroll
            for (int m = 0; m < 4; ++m) {
                const pg8::f32x4 g0 = acc[ai][0][m][0], g1 = acc[ai][0][m][1], u0 = acc[ai][1][m][0], u1 = acc[ai][1][m][1];
                u32x4 w;
                w.x = pg8::cvt_pk_bf16(silu_f(g0[0]) * u0[0], silu_f(g0[1]) * u0[1]); w.y = pg8::cvt_pk_bf16(silu_f(g0[2]) * u0[2], silu_f(g0[3]) * u0[3]);
                w.z = pg8::cvt_pk_bf16(silu_f(g1[0]) * u1[0], silu_f(g1[1]) * u1[1]); w.w = pg8::cvt_pk_bf16(silu_f(g1[2]) * u1[2], silu_f(g1[3]) * u1[3]);
                *(u32x4*)(O + (size_t)(row0 + ai * 128 + m * 16) * DFF + col0) = w;
            }
    }
};
struct EpiResid {
    static constexpr bool PERM = true, AFTER_DRAIN = false;
    const float* res; float* out; float scale;
    __device__ __forceinline__ void operator()(const pg8::f32x4 (&acc)[2][2][4][2], const pg8::Unit& u, int wr, int wc, int fr, int fq) const {
        const int row0 = u.pm * 256 + wr * 64 + fr, col0 = u.pn * 256 + wc * 32 + 8 * fq;
#pragma unroll
        for (int ai = 0; ai < 2; ++ai)
#pragma unroll
            for (int m = 0; m < 4; ++m)
#pragma unroll
                for (int bj = 0; bj < 2; ++bj) {
                    const size_t off = (size_t)(row0 + ai * 128 + m * 16) * DM + col0 + bj * 128;
                    const f32x4 r0 = *(const f32x4*)(res + off), r1 = *(const f32x4*)(res + off + 4);
                    f32x4 o0, o1;
#pragma unroll
                    for (int e = 0; e < 4; ++e) { o0[e] = ALPHA * r0[e] + scale * acc[ai][bj][m][0][e]; o1[e] = ALPHA * r1[e] + scale * acc[ai][bj][m][1][e]; }
                    *(f32x4*)(out + off) = o0; *(f32x4*)(out + off + 4) = o1;
                }
    }
};
struct EpiProj {
    static constexpr bool PERM = true, AFTER_DRAIN = false;
    bf16 *AV, *AG, *BQ, *BK, *BVT, *CQ, *CK, *CVT1, *CVT4, *CVT16; const float* rope;
    __device__ __forceinline__ void operator()(const pg8::f32x4 (&acc)[2][2][4][2], const pg8::Unit& u, int wr, int wc, int fr, int fq) const {
        const int pn = u.pn;
        const int rbase = u.pm * 256 + wr * 64;
        if (pn <= 3) {
#pragma unroll
            for (int ai = 0; ai < 2; ++ai)
#pragma unroll
                for (int m = 0; m < 4; ++m)
#pragma unroll
                    for (int bj = 0; bj < 2; ++bj) {
                        const int row = rbase + ai * 128 + m * 16 + fr, cl = bj * 128 + wc * 32 + 8 * fq;
                        const pg8::f32x4 v0 = acc[ai][bj][m][0], v1 = acc[ai][bj][m][1];
                        u32x4 w; w.x = pg8::cvt_pk_bf16(v0[0], v0[1]); w.y = pg8::cvt_pk_bf16(v0[2], v0[3]); w.z = pg8::cvt_pk_bf16(v1[0], v1[1]); w.w = pg8::cvt_pk_bf16(v1[2], v1[3]);
                        if (pn <= 1) { bf16* dst = (pn == 0 ? AV : AG) + (size_t)row * 256 + cl; *(u32x4*)dst = w; }
                        else { const int b = row >> 12, s = row & 4095, head = cl >> 6, dd = cl & 63;
                               bf16* dst = (pn == 2 ? BQ : BK) + ((size_t)((b * 4 + head) * 4096 + s)) * 64 + dd; *(u32x4*)dst = w; }
                    }
        } else if (pn == 4) {
#pragma unroll
            for (int ai = 0; ai < 2; ++ai)
#pragma unroll
                for (int m = 0; m < 4; ++m)
#pragma unroll
                    for (int bj = 0; bj < 2; ++bj) {
                        const int row = rbase + ai * 128 + m * 16 + fr, cl = bj * 128 + wc * 32 + 8 * fq;
                        const int b = row >> 12, s = row & 4095, head = cl >> 6, dd = cl & 63;
                        bf16* dst = BVT + ((size_t)((b * 4 + head) * 64 + dd)) * 4096 + s;
#pragma unroll
                        for (int n = 0; n < 2; ++n)
#pragma unroll
                            for (int e = 0; e < 4; ++e) dst[(size_t)(4 * n + e) * 4096] = f2bf(acc[ai][bj][m][n][e]);
                    }
        } else if (pn <= 8) {
            const bool isq = pn <= 6; const float sc = isq ? 0.125f * LOG2E : 1.0f;   const int hb = ((pn - 5) & 1) * 4;
            bf16* base = isq ? CQ : CK;
#pragma unroll
            for (int ai = 0; ai < 2; ++ai)
#pragma unroll
                for (int m = 0; m < 4; ++m)
#pragma unroll
                    for (int bj = 0; bj < 2; ++bj) {
                        const int row = rbase + ai * 128 + m * 16 + fr, cl = bj * 128 + wc * 32 + 8 * fq;
                        const int b = row >> 12, s = row & 4095, head = hb + (cl >> 6), dd = cl & 63, i0 = dd >> 1;
                        const f32x4 c4 = *(const f32x4*)(rope + (size_t)s * 32 + i0), s4 = *(const f32x4*)(rope + 4096 * 32 + (size_t)s * 32 + i0);
                        const pg8::f32x4 v0 = acc[ai][bj][m][0], v1 = acc[ai][bj][m][1];
                        u32x4 w;
                        w.x = pg8::cvt_pk_bf16((v0[0] * c4[0] - v0[1] * s4[0]) * sc, (v0[1] * c4[0] + v0[0] * s4[0]) * sc);
                        w.y = pg8::cvt_pk_bf16((v0[2] * c4[1] - v0[3] * s4[1]) * sc, (v0[3] * c4[1] + v0[2] * s4[1]) * sc);
                        w.z = pg8::cvt_pk_bf16((v1[0] * c4[2] - v1[1] * s4[2]) * sc, (v1[1] * c4[2] + v1[0] * s4[2]) * sc);
                        w.w = pg8::cvt_pk_bf16((v1[2] * c4[3] - v1[3] * s4[3]) * sc, (v1[3] * c4[3] + v1[2] * s4[3]) * sc);
                        *(u32x4*)(base + ((size_t)((b * 8 + head) * 4096 + s)) * 64 + dd) = w;
                    }
        } else {
            const int hb = (pn - 9) * 4;
#pragma unroll
            for (int ai = 0; ai < 2; ++ai)
#pragma unroll
                for (int bj = 0; bj < 2; ++bj) {
                    const int cl = bj * 128 + wc * 32 + 8 * fq, head = hb + (cl >> 6), dd = cl & 63;
                    const int row_b = rbase + ai * 128, b = row_b >> 12, sb = row_b & 4095;
                    bf16* p1 = CVT1 + ((size_t)((b * 8 + head) * 64 + dd)) * 4096;
                    bf16* p4 = CVT4 + ((size_t)((b * 8 + head) * 64 + dd)) * 4096;
                    bf16* p16 = CVT16 + ((size_t)((b * 8 + head) * 64 + dd)) * 4096;
#pragma unroll
                    for (int n = 0; n < 2; ++n)
#pragma unroll
                        for (int e = 0; e < 4; ++e) {
                            const size_t co = (size_t)(4 * n + e) * 4096;
                            const float x0 = acc[ai][bj][0][n][e], x1 = acc[ai][bj][1][n][e], x2 = acc[ai][bj][2][n][e], x3 = acc[ai][bj][3][n][e];
                            u32x2 w16; w16.x = pg8::cvt_pk_bf16(x0, x1); w16.y = pg8::cvt_pk_bf16(x2, x3);
                            *(u32x2*)(p16 + co + fr * 256 + (sb >> 4)) = w16;
                            const unsigned short h0 = (unsigned short)(w16.x & 0xffffu), h1 = (unsigned short)(w16.x >> 16), h2 = (unsigned short)(w16.y & 0xffffu), h3 = (unsigned short)(w16.y >> 16);
                            p1[co + sb + fr] = h0; p1[co + sb + 16 + fr] = h1; p1[co + sb + 32 + fr] = h2; p1[co + sb + 48 + fr] = h3;
                            bf16* q4 = p4 + co + (fr & 3) * 1024 + ((sb + fr) >> 2);
                            q4[0] = h0; q4[4] = h1; q4[8] = h2; q4[12] = h3;
                        }
                }
        }
    }
};

struct Args {
    const float *x, *w_in, *w_o, *fbias, *conv_w, *conv_b, *conv_g, *conv_beta, *ffn_w_in, *ffn_w_out, *ln_g, *ln_b;
    float* out; unsigned char* ws;
};

__device__ __forceinline__ int src_col(int mode, int n) {
    if (mode == 1) return ((n & 255) >> 7) * DFF + (n >> 8) * 128 + (n & 127);
    if (mode == 2) { if (n < 1280) return n; const int np = n - 1280; if (np < 1024) { const int p = np & 63; return 1284 + (np & ~63) + (p >> 1) + 32 * (p & 1); } return 1284 + np; }
    return n;
}
__device__ __forceinline__ void transpose_item(const float* __restrict__ W, int K, int Nsrc, bf16* __restrict__ Wt, int mode, int kb, int nb, LAS float* t, int tid) {
    const int k0 = kb * 64, n0 = nb * 64, nl = tid & 63, sc = src_col(mode, n0 + nl);
#pragma unroll
    for (int i = 0; i < 8; ++i) { const int kk = (tid >> 6) + 8 * i; t[kk * 65 + nl] = W[(size_t)(k0 + kk) * Nsrc + sc]; }
    __syncthreads();
    const int n2 = tid >> 3, kc = (tid & 7) * 8;
    u32x4 w;
    w.x = cvtpk(t[(kc + 0) * 65 + n2], t[(kc + 1) * 65 + n2]); w.y = cvtpk(t[(kc + 2) * 65 + n2], t[(kc + 3) * 65 + n2]);
    w.z = cvtpk(t[(kc + 4) * 65 + n2], t[(kc + 5) * 65 + n2]); w.w = cvtpk(t[(kc + 6) * 65 + n2], t[(kc + 7) * 65 + n2]);
    *(u32x4*)(Wt + (size_t)(n0 + n2) * K + k0 + kc) = w;
    __syncthreads();
}
__device__ __forceinline__ void prologue(const Args& a, LAS unsigned char* lds) {
    const int tid = threadIdx.x, G = gridDim.x, bx = blockIdx.x;
    unsigned char* ws = a.ws;
    if (bx == 0) { if (tid < 64) ((unsigned*)(ws + WS_CTL))[tid] = 0u;
        for (int i = tid; i < XCD_BAR_WORDS; i += NTHR) ((unsigned*)(ws + WS_CTL))[CW_BAR + i] = 0u; }
    { float* rc = (float*)(ws + WS_ROPE); float* rs = rc + 4096 * 32;
      for (int i = bx * NTHR + tid; i < 4096 * 32; i += G * NTHR) { const int pos = i >> 5, j = i & 31;
          const float inv = (float)(1.0 / pow(10000.0, (double)(2 * j) / 64.0)); const float ang = (float)pos * inv;
          rc[i] = (float)cos((double)ang); rs[i] = (float)sin((double)ang); } }
    { bf16* hb = (bf16*)(ws + WS_HB);
      for (size_t i = (size_t)bx * NTHR + tid; i < (size_t)MTOK * DM / 8; i += (size_t)G * NTHR) {
          const f32x4 v0 = *(const f32x4*)(a.x + i * 8), v1 = *(const f32x4*)(a.x + i * 8 + 4);
          u32x4 w; w.x = cvtpk(v0[0], v0[1]); w.y = cvtpk(v0[2], v0[3]); w.z = cvtpk(v1[0], v1[1]); w.w = cvtpk(v1[2], v1[3]);
          *(u32x4*)(hb + i * 8) = w; } }
    LAS float* t = (LAS float*)lds;
    constexpr int I1 = 16 * 88, I2 = 44 * 16, I3 = 16 * 44, I4 = 16 * 16, NIT = 4 * I1 + 4 * I2 + 2 * I3 + 2 * I4;
    for (int it = bx; it < NIT; it += G) {
        int r = it;
        if (r < 4 * I1) { const int mi = r / I1, q = r % I1; transpose_item(a.ffn_w_in + (size_t)mi * 1024 * 5632, 1024, 5632, (bf16*)(ws + WS_W1T) + (size_t)mi * 5632 * 1024, 1, q / 88, q % 88, t, tid); continue; }
        r -= 4 * I1;
        if (r < 4 * I2) { const int mi = r / I2, q = r % I2; transpose_item(a.ffn_w_out + (size_t)mi * DFF * 1024, DFF, 1024, (bf16*)(ws + WS_W2T) + (size_t)mi * 1024 * DFF, 0, q / 16, q % 16, t, tid); continue; }
        r -= 4 * I2;
        if (r < 2 * I3) { const int mi = r / I3, q = r % I3; transpose_item(a.w_in + (size_t)mi * 1024 * INCOLS, 1024, INCOLS, (bf16*)(ws + WS_WINT) + (size_t)mi * NPROJ * 1024, 2, q / 44, q % 44, t, tid); continue; }
        r -= 2 * I3;
        { const int mi = r / I4, q = r % I4; transpose_item(a.w_o + (size_t)mi * 1024 * 1024, 1024, 1024, (bf16*)(ws + WS_WOT) + (size_t)mi * 1024 * 1024, 0, q / 16, q % 16, t, tid); }
    }
}

__device__ __forceinline__ void ln_phase(float* Y, bf16* HB, const float* __restrict__ g, const float* __restrict__ bt, bool fgate, const float* __restrict__ w_in_l,
                                         const float* __restrict__ fbias, float* lgf, LAS unsigned char* lds) {
    int tid_ = threadIdx.x; asm volatile("" : "+v"(tid_));
    const int tid = tid_, lane = tid & 63, wid = tid >> 6, G = gridDim.x;
    LAS f32x4* wf = (LAS f32x4*)lds;
    if (fgate) { for (int k = tid; k < 1024; k += NTHR) wf[k] = *(const f32x4*)(w_in_l + (size_t)k * INCOLS + 1280); }
    __syncthreads();
    f32x4 gv[4], bv[4];
#pragma unroll
    for (int j = 0; j < 4; ++j) { gv[j] = *(const f32x4*)(g + 256 * j + 4 * lane); bv[j] = *(const f32x4*)(bt + 256 * j + 4 * lane); }
    for (int row = blockIdx.x * 8 + wid; row < MTOK; row += G * 8) {
        float* yr = Y + (size_t)row * DM;
        f32x4 v[4]; float s = 0.f;
#pragma unroll
        for (int j = 0; j < 4; ++j) { v[j] = *(const f32x4*)(yr + 256 * j + 4 * lane); s += (v[j][0] + v[j][1]) + (v[j][2] + v[j][3]); }
        const float mean = wave_sum(s) * (1.f / DM); float s2 = 0.f;
#pragma unroll
        for (int j = 0; j < 4; ++j) { v[j] = v[j] - mean; s2 += (v[j][0] * v[j][0] + v[j][1] * v[j][1]) + (v[j][2] * v[j][2] + v[j][3] * v[j][3]); }
        const float rstd = 1.0f / sqrtf(wave_sum(s2) * (1.f / DM) + LN_EPS);
        f32x4 z = {0.f, 0.f, 0.f, 0.f};
#pragma unroll
        for (int j = 0; j < 4; ++j) {
            f32x4 o;
#pragma unroll
            for (int e = 0; e < 4; ++e) o[e] = v[j][e] * rstd * gv[j][e] + bv[j][e];
            *(f32x4*)(yr + 256 * j + 4 * lane) = o;
            u32x2 w; w.x = cvtpk(o[0], o[1]); w.y = cvtpk(o[2], o[3]);
            *(u32x2*)(HB + (size_t)row * DM + 256 * j + 4 * lane) = w;
            if (fgate) {
#pragma unroll
                for (int e = 0; e < 4; ++e) { const f32x4 wv = wf[256 * j + 4 * lane + e]; z = z + wv * o[e]; }
            }
        }
        if (fgate) {
            z[0] = wave_sum(z[0]); z[1] = wave_sum(z[1]); z[2] = wave_sum(z[2]); z[3] = wave_sum(z[3]);
            if (lane < 4) { const float zz = (lane == 0 ? z[0] : lane == 1 ? z[1] : lane == 2 ? z[2] : z[3]) + fbias[lane];
                const float ls = fminf(zz, 0.f) - log1pf(expf(-fabsf(zz)));
                lgf[(size_t)(((row >> 12) * 4 + lane)) * 4096 + (row & 4095)] = ls; }
        }
    }
    __syncthreads();
}

#define MFMA32(a, b, c) __builtin_amdgcn_mfma_f32_32x32x16_bf16((a), (b), (c), 0, 0, 0)
__device__ __forceinline__ bf16x8 pack8(const f32x16& x, int s) {
    u32x4 p; p.x = cvtpk(x[8 * s + 0], x[8 * s + 1]); p.y = cvtpk(x[8 * s + 2], x[8 * s + 3]); p.z = cvtpk(x[8 * s + 4], x[8 * s + 5]); p.w = cvtpk(x[8 * s + 6], x[8 * s + 7]);
    return __builtin_bit_cast(bf16x8, p);
}
__device__ __forceinline__ float ex2(float x) { return __builtin_amdgcn_exp2f(x); }
#define PAIR(v, p) ((f32x2_t){(v)[2 * (p)], (v)[2 * (p) + 1]})
__device__ __forceinline__ void softmax_step(f32x16& st, f32x16& o0, f32x16& o1, float& m_run, float& l_run) {
    float mx = fmaxf(fmaxf(st[0], st[1]), fmaxf(st[2], st[3]));
#pragma unroll
    for (int i = 4; i < 16; i += 2) mx = fmaxf(mx, fmaxf(st[i], st[i + 1]));
    mx = fmaxf(mx, __shfl_xor(mx, 32));
    const float m_new = fmaxf(m_run, mx);
    if (__any(m_new > m_run)) {
        const float al = ex2(m_run - m_new);
        const f32x2_t al2 = {al, al};
#pragma unroll
        for (int p = 0; p < 8; ++p) {
            const f32x2_t a = PAIR(o0, p) * al2, c = PAIR(o1, p) * al2;
            o0[2 * p] = a[0]; o0[2 * p + 1] = a[1]; o1[2 * p] = c[0]; o1[2 * p + 1] = c[1];
        }
        l_run *= al; m_run = m_new;
    }
    const f32x2_t mm = {m_run, m_run};
    f32x2_t ps = {0.f, 0.f};
#pragma unroll
    for (int p = 0; p < 8; ++p) {
        const f32x2_t d = PAIR(st, p) - mm;
        f32x2_t e; e[0] = ex2(d[0]); e[1] = ex2(d[1]);
        ps = ps + e; st[2 * p] = e[0]; st[2 * p + 1] = e[1];
    }
    l_run += ps[0] + ps[1];
}

constexpr int FK_OFF = 0, FV_OFF = 18432, FCUM_OFF = 36864, FSCR_OFF = 53248, KV_PITCH = 144;

template <bool DIAG>
__device__ __forceinline__ void fox_tile(LAS unsigned char* Kb, LAS unsigned char* Vb, const LAS float* cumk, const bf16x8 (&qf)[4], float cq2, int kbase, int qrow, int r, int h,
                                         f32x16& o0, f32x16& o1, float& m_run, float& l_run) {
    f32x16 st0, st1;
#pragma unroll
    for (int i = 0; i < 16; ++i) { st0[i] = 0.f; st1[i] = 0.f; }
#pragma unroll
    for (int ks = 0; ks < 4; ++ks) {
        const bf16x8 a0 = *(const LAS bf16x8*)(Kb + r * KV_PITCH + (16 * ks + 8 * h) * 2);
        const bf16x8 a1 = *(const LAS bf16x8*)(Kb + (32 + r) * KV_PITCH + (16 * ks + 8 * h) * 2);
        st0 = MFMA32(a0, qf[ks], st0); st1 = MFMA32(a1, qf[ks], st1);
    }
    const float C1 = 0.125f * LOG2E;
    const f32x2_t c1v = {C1, C1}, cqv = {cq2, cq2};
#pragma unroll
    for (int gq = 0; gq < 4; ++gq) {
        const f32x4 c0 = *(const LAS f32x4*)(cumk + 8 * gq + 4 * h), c1 = *(const LAS f32x4*)(cumk + 32 + 8 * gq + 4 * h);
#pragma unroll
        for (int pp = 0; pp < 2; ++pp) {
            const int p = 2 * gq + pp;
            const f32x2_t b0 = cqv - (f32x2_t){c0[2 * pp], c0[2 * pp + 1]}, b1 = cqv - (f32x2_t){c1[2 * pp], c1[2 * pp + 1]};
            f32x2_t x0 = PAIR(st0, p) * c1v + b0, x1 = PAIR(st1, p) * c1v + b1;
            if (DIAG) {
                const int key0 = kbase + 8 * gq + 4 * h + 2 * pp;
                if (key0 > qrow) x0[0] = -INFINITY; if (key0 + 1 > qrow) x0[1] = -INFINITY;
                if (key0 + 32 > qrow) x1[0] = -INFINITY; if (key0 + 33 > qrow) x1[1] = -INFINITY;
            }
            st0[2 * p] = x0[0]; st0[2 * p + 1] = x0[1]; st1[2 * p] = x1[0]; st1[2 * p + 1] = x1[1];
        }
    }
    {
        float mx = fmaxf(fmaxf(st0[0], st0[1]), fmaxf(st1[0], st1[1]));
#pragma unroll
        for (int i = 2; i < 16; i += 2) mx = fmaxf(mx, fmaxf(fmaxf(st0[i], st0[i + 1]), fmaxf(st1[i], st1[i + 1])));
        mx = fmaxf(mx, __shfl_xor(mx, 32));
        const float m_new = fmaxf(m_run, mx);
        if (__any(m_new > m_run)) {
            const float al = ex2(m_run - m_new);
            const f32x2_t al2 = {al, al};
#pragma unroll
            for (int p = 0; p < 8; ++p) {
                const f32x2_t a = PAIR(o0, p) * al2, c = PAIR(o1, p) * al2;
                o0[2 * p] = a[0]; o0[2 * p + 1] = a[1]; o1[2 * p] = c[0]; o1[2 * p + 1] = c[1];
            }
            l_run *= al; m_run = m_new;
        }
        const f32x2_t mm = {m_run, m_run};
        f32x2_t ps = {0.f, 0.f};
#pragma unroll
        for (int p = 0; p < 8; ++p) {
            const f32x2_t d0 = PAIR(st0, p) - mm, d1 = PAIR(st1, p) - mm;
            f32x2_t e0, e1; e0[0] = ex2(d0[0]); e0[1] = ex2(d0[1]); e1[0] = ex2(d1[0]); e1[1] = ex2(d1[1]);
            ps = ps + e0; ps = ps + e1;
            st0[2 * p] = e0[0]; st0[2 * p + 1] = e0[1]; st1[2 * p] = e1[0]; st1[2 * p + 1] = e1[1];
        }
        l_run += ps[0] + ps[1];
    }
#pragma unroll
    for (int s2 = 0; s2 < 2; ++s2) {
        const bf16x8 p0 = pack8(st0, s2), p1 = pack8(st1, s2);
#pragma unroll
        for (int ds = 0; ds < 2; ++ds) {
            const LAS unsigned char* vr = Vb + (32 * ds + r) * KV_PITCH;
            const s16x4 lo0 = *(const LAS s16x4*)(vr + (16 * s2 + 4 * h) * 2), hi0 = *(const LAS s16x4*)(vr + (16 * s2 + 8 + 4 * h) * 2);
            const s16x4 lo1 = *(const LAS s16x4*)(vr + (32 + 16 * s2 + 4 * h) * 2), hi1 = *(const LAS s16x4*)(vr + (32 + 16 * s2 + 8 + 4 * h) * 2);
            const bf16x8 va0 = __builtin_shufflevector(lo0, hi0, 0, 1, 2, 3, 4, 5, 6, 7), va1 = __builtin_shufflevector(lo1, hi1, 0, 1, 2, 3, 4, 5, 6, 7);
            if (ds == 0) { o0 = MFMA32(va0, p0, o0); o0 = MFMA32(va1, p1, o0); } else { o1 = MFMA32(va0, p0, o1); o1 = MFMA32(va1, p1, o1); }
        }
    }
}

__device__ __forceinline__ void fox_unit(LAS unsigned char* lds, int b, int head, int qb, const bf16* __restrict__ BQ, const bf16* __restrict__ BK, const bf16* __restrict__ BVT,
                                         const float* __restrict__ lgf, bf16* YCAT) {
    int tid_ = threadIdx.x; asm volatile("" : "+v"(tid_));
    const int tid = tid_, lane = tid & 63, wid = tid >> 6, r = lane & 31, h = lane >> 5;
    const int q0 = qb * 256, kend = q0 + 256, ntiles = kend / 64, bh = b * 4 + head;
    LAS float* cum = (LAS float*)(lds + FCUM_OFF); LAS float* scr = (LAS float*)(lds + FSCR_OFF);
    {
        const float* lf = lgf + (size_t)bh * 4096;
        float v[8];
        if (8 * tid < kend) { const f32x4 a0 = *(const f32x4*)(lf + 8 * tid), a1 = *(const f32x4*)(lf + 8 * tid + 4); v[0] = a0[0]; v[1] = a0[1]; v[2] = a0[2]; v[3] = a0[3]; v[4] = a1[0]; v[5] = a1[1]; v[6] = a1[2]; v[7] = a1[3]; }
        else {
#pragma unroll
            for (int j = 0; j < 8; ++j) v[j] = 0.f; }
#pragma unroll
        for (int j = 1; j < 8; ++j) v[j] += v[j - 1];
        const float total = v[7]; float t = total;
#pragma unroll
        for (int o = 1; o < 64; o <<= 1) { const float n = __shfl_up(t, o); if (lane >= o) t += n; }
        if (lane == 63) scr[wid] = t;
        __syncthreads();
        float woff = 0.f;
        for (int w = 0; w < wid; ++w) woff += scr[w];
        const float base = woff + t - total;
#pragma unroll
        for (int j = 0; j < 8; ++j) cum[8 * tid + j] = (base + v[j]) * LOG2E;
    }
    __syncthreads();
    const int qrow = q0 + 32 * wid + r;
    bf16x8 qf[4];
    { const bf16* qp = BQ + ((size_t)bh * 4096 + qrow) * 64 + 8 * h;
#pragma unroll
      for (int ks = 0; ks < 4; ++ks) qf[ks] = *(const bf16x8*)(qp + 16 * ks); }
    const float cq2 = cum[qrow];
    const int my_last = (q0 + 32 * wid + 31) >> 6;
    f32x16 o0, o1;
#pragma unroll
    for (int i = 0; i < 16; ++i) { o0[i] = 0.f; o1[i] = 0.f; }
    float m_run = -INFINITY, l_run = 0.f;
    const int srow = tid >> 3, sch = tid & 7;
    const bf16* kg = BK + ((size_t)bh * 4096 + srow) * 64 + sch * 8;
    const bf16* vg = BVT + ((size_t)bh * 64 + srow) * 4096 + sch * 8;
    const int soff = srow * KV_PITCH + sch * 16;
    u32x4 kreg = *(const u32x4*)(kg + (size_t)(ntiles - 1) * 4096), vreg = *(const u32x4*)(vg + (ntiles - 1) * 64);
    *(LAS u32x4*)(lds + FK_OFF + soff) = kreg; *(LAS u32x4*)(lds + FV_OFF + soff) = vreg;
    __syncthreads();
    int buf = 0;
    for (int kt = ntiles - 1; kt >= 0; --kt) {
        if (kt > 0) { kreg = *(const u32x4*)(kg + (size_t)(kt - 1) * 4096); vreg = *(const u32x4*)(vg + (kt - 1) * 64); }
        if (kt <= my_last) {
            LAS unsigned char* Kb = lds + FK_OFF + buf * 9216; LAS unsigned char* Vb = lds + FV_OFF + buf * 9216;
            const int kbase = kt * 64;
            if ((kbase + 63) > (q0 + 32 * wid)) fox_tile<true>(Kb, Vb, cum + kbase, qf, cq2, kbase, qrow, r, h, o0, o1, m_run, l_run);
            else fox_tile<false>(Kb, Vb, cum + kbase, qf, cq2, kbase, qrow, r, h, o0, o1, m_run, l_run);
        }
        if (kt > 0) { *(LAS u32x4*)(lds + FK_OFF + (buf ^ 1) * 9216 + soff) = kreg; *(LAS u32x4*)(lds + FV_OFF + (buf ^ 1) * 9216 + soff) = vreg; }
        __syncthreads();
        buf ^= 1;
    }
    const float lt = l_run + __shfl_xor(l_run, 32), inv = 1.0f / lt;
    bf16* yo = YCAT + ((size_t)(b * 4096 + qrow)) * DM + 256 + head * 64 + 4 * h;
#pragma unroll
    for (int gq = 0; gq < 4; ++gq) {
        u32x2 w0, w1;
        w0.x = cvtpk(o0[4 * gq] * inv, o0[4 * gq + 1] * inv); w0.y = cvtpk(o0[4 * gq + 2] * inv, o0[4 * gq + 3] * inv);
        w1.x = cvtpk(o1[4 * gq] * inv, o1[4 * gq + 1] * inv); w1.y = cvtpk(o1[4 * gq + 2] * inv, o1[4 * gq + 3] * inv);
        *(u32x2*)(yo + 8 * gq) = w0; *(u32x2*)(yo + 32 + 8 * gq) = w1;
    }
}

constexpr int DO_OFF = 0, DM_OFF = 65536, DL_OFF = 67584, DST_OFF = 69632, DST_WAVE = 9216, DK_PITCH = 144, DV_PITCH = 72, DV_OFF = 4608;
__device__ __forceinline__ int dswz(int p) { return (p & ~31) | ((p ^ (p >> 4)) & 31); }

struct DilStage { u32x4 k[4]; u32x4 v[4]; };
__device__ __forceinline__ void dil_gload(DilStage& s, const bf16* __restrict__ CKh, const bf16* __restrict__ VT, int msk, int lgd, int res, int nsubidx, int lane) {
#pragma unroll
    for (int i = 0; i < 4; ++i) {
        int pos = ((msk + (lane >> 3) + 8 * i) << lgd) + res; pos = pos < 0 ? 0 : (pos > 4095 ? 4095 : pos);
        s.k[i] = *(const u32x4*)(CKh + (size_t)pos * 64 + (lane & 7) * 8);
    }
    int c = msk + 8 * (lane & 3); c = (c < 0 || c >= nsubidx) ? 0 : c;
#pragma unroll
    for (int i = 0; i < 4; ++i) s.v[i] = *(const u32x4*)(VT + (size_t)((lane >> 2) + 16 * i) * 4096 + c);
}
__device__ __forceinline__ void dil_lstore(const DilStage& s, LAS unsigned char* st, int lane) {
#pragma unroll
    for (int i = 0; i < 4; ++i) *(LAS u32x4*)(st + ((lane >> 3) + 8 * i) * DK_PITCH + (lane & 7) * 16) = s.k[i];
#pragma unroll
    for (int i = 0; i < 4; ++i) {
        LAS unsigned char* p = st + DV_OFF + ((lane >> 2) + 16 * i) * DV_PITCH + (lane & 3) * 16;
        *(LAS u32x2*)p = (u32x2){s.v[i].x, s.v[i].y}; *(LAS u32x2*)(p + 8) = (u32x2){s.v[i].z, s.v[i].w};
    }
}
template <int MODE>
__device__ __forceinline__ void dil_tile(const LAS unsigned char* st_, const bf16x8 (&qf)[4], int r, int h, f32x16& o0, f32x16& o1, float& m_run, float& l_run) {
    f32x16 st;
#pragma unroll
    for (int i = 0; i < 16; ++i) st[i] = 0.f;
#pragma unroll
    for (int ks = 0; ks < 4; ++ks) { const bf16x8 ka = *(const LAS bf16x8*)(st_ + r * DK_PITCH + (16 * ks + 8 * h) * 2); st = MFMA32(ka, qf[ks], st); }
    if (MODE != 0) {
#pragma unroll
        for (int i = 0; i < 16; ++i) {
            const int cr = (i & 3) + 8 * (i >> 2) + 4 * h;
            const bool valid = (MODE == 1) ? (cr <= r) : (cr >= r);
            st[i] = valid ? st[i] : -INFINITY;
        }
    }
    softmax_step(st, o0, o1, m_run, l_run);
#pragma unroll
    for (int s2 = 0; s2 < 2; ++s2) {
        const bf16x8 p = pack8(st, s2);
#pragma unroll
        for (int ds = 0; ds < 2; ++ds) {
            const LAS unsigned char* vr = st_ + DV_OFF + (32 * ds + r) * DV_PITCH + (16 * s2 + 4 * h) * 2;
            const s16x4 lo = *(const LAS s16x4*)vr, hi = *(const LAS s16x4*)(vr + 16);
            const bf16x8 va = __builtin_shufflevector(lo, hi, 0, 1, 2, 3, 4, 5, 6, 7);
            if (ds == 0) o0 = MFMA32(va, p, o0); else o1 = MFMA32(va, p, o1);
        }
    }
}

__device__ __forceinline__ void dil_unit(LAS unsigned char* lds, int b, int head, int blk, const bf16* __restrict__ CQ, const bf16* __restrict__ CK, const bf16* __restrict__ CVT1,
                                         const bf16* __restrict__ CVT4, const bf16* __restrict__ CVT16, bf16* YCAT) {
    int tid_ = threadIdx.x; asm volatile("" : "+v"(tid_));
    const int tid = tid_, lane = tid & 63, wid = tid >> 6, r = lane & 31, h = lane >> 5;
    const int t0 = blk * 512, bh = b * 8 + head;
    LAS unsigned* OL = (LAS unsigned*)(lds + DO_OFF); LAS float* ML = (LAS float*)(lds + DM_OFF); LAS float* LL = (LAS float*)(lds + DL_OFF);
    LAS unsigned char* stg = lds + DST_OFF + wid * DST_WAVE;
    const bf16* CKh = CK + (size_t)bh * 4096 * 64;
    for (int bi = 0; bi < 3; ++bi) {
        const int lgd = 4 - 2 * bi, d = 1 << lgd, nsubidx = 4096 >> lgd;
        const bf16* VTb = (bi == 0 ? CVT16 : bi == 1 ? CVT4 : CVT1) + (size_t)bh * 64 * 4096;
        for (int gi = 0; gi < 2; ++gi) {
            const int g = 2 * wid + gi, res = g & (d - 1), mb = g >> lgd;
            const int mq0 = (t0 >> lgd) + 32 * mb, ms0 = mq0 - 128;
            const int pos = ((mq0 + r) << lgd) + res, posl = pos - t0;
            const bf16* VT = VTb + (size_t)res * nsubidx;
            DilStage sg;
            dil_gload(sg, CKh, VT, ms0 + 128, lgd, res, nsubidx, lane);
            bf16x8 qf[4];
            { const bf16* qp = CQ + ((size_t)bh * 4096 + pos) * 64 + 8 * h;
#pragma unroll
              for (int ks = 0; ks < 4; ++ks) qf[ks] = *(const bf16x8*)(qp + 16 * ks); }
            f32x16 o0, o1;
#pragma unroll
            for (int i = 0; i < 16; ++i) { o0[i] = 0.f; o1[i] = 0.f; }
            float m_run = -INFINITY, l_run = 0.f;
            dil_lstore(sg, stg, lane);
            dil_gload(sg, CKh, VT, ms0 + 96, lgd, res, nsubidx, lane);
            dil_tile<1>(stg, qf, r, h, o0, o1, m_run, l_run);
            if (ms0 + 96 >= 0) {
                dil_lstore(sg, stg, lane);
                dil_gload(sg, CKh, VT, ms0 + 64, lgd, res, nsubidx, lane);
                dil_tile<0>(stg, qf, r, h, o0, o1, m_run, l_run);
                if (ms0 + 64 >= 0) {
                    dil_lstore(sg, stg, lane);
                    dil_gload(sg, CKh, VT, ms0 + 32, lgd, res, nsubidx, lane);
                    dil_tile<0>(stg, qf, r, h, o0, o1, m_run, l_run);
                    if (ms0 + 32 >= 0) {
                        dil_lstore(sg, stg, lane);
                        dil_gload(sg, CKh, VT, ms0, lgd, res, nsubidx, lane);
                        dil_tile<0>(stg, qf, r, h, o0, o1, m_run, l_run);
                        if (ms0 >= 0) { dil_lstore(sg, stg, lane); dil_tile<2>(stg, qf, r, h, o0, o1, m_run, l_run); }
                    }
                }
            }
            const float lt = l_run + __shfl_xor(l_run, 32);
            const int sidx = dswz(posl);
            if (bi == 0) {
                ML[posl] = m_run; LL[posl] = lt;
#pragma unroll
                for (int k = 0; k < 8; ++k) { const int row = 4 * (k >> 1) + 2 * h + (k & 1);
                    OL[row * 512 + sidx] = cvtpk(o0[2 * k], o0[2 * k + 1]); OL[(16 + row) * 512 + sidx] = cvtpk(o1[2 * k], o1[2 * k + 1]); }
            } else {
                const float m_old = ML[posl], l_old = LL[posl];
                const float m_new = fmaxf(m_old, m_run), a_old = ex2(m_old - m_new), a_new = ex2(m_run - m_new);
                const float l_new = l_old * a_old + lt * a_new;
                if (bi == 1) {
                    ML[posl] = m_new; LL[posl] = l_new;
#pragma unroll
                    for (int k = 0; k < 8; ++k) { const int row = 4 * (k >> 1) + 2 * h + (k & 1);
                        const unsigned w0 = OL[row * 512 + sidx], w1 = OL[(16 + row) * 512 + sidx];
                        OL[row * 512 + sidx] = cvtpk(__builtin_bit_cast(float, w0 << 16) * a_old + o0[2 * k] * a_new, __builtin_bit_cast(float, w0 & 0xffff0000u) * a_old + o0[2 * k + 1] * a_new);
                        OL[(16 + row) * 512 + sidx] = cvtpk(__builtin_bit_cast(float, w1 << 16) * a_old + o1[2 * k] * a_new, __builtin_bit_cast(float, w1 & 0xffff0000u) * a_old + o1[2 * k + 1] * a_new); }
                } else {
                    const float inv = 1.0f / l_new, s_old = a_old * inv, s_new = a_new * inv;
#pragma unroll
                    for (int k = 0; k < 8; ++k) { const int row = 4 * (k >> 1) + 2 * h + (k & 1);
                        const unsigned w0 = OL[row * 512 + sidx], w1 = OL[(16 + row) * 512 + sidx];
                        o0[2 * k] = __builtin_bit_cast(float, w0 << 16) * s_old + o0[2 * k] * s_new; o0[2 * k + 1] = __builtin_bit_cast(float, w0 & 0xffff0000u) * s_old + o0[2 * k + 1] * s_new;
                        o1[2 * k] = __builtin_bit_cast(float, w1 << 16) * s_old + o1[2 * k] * s_new; o1[2 * k + 1] = __builtin_bit_cast(float, w1 & 0xffff0000u) * s_old + o1[2 * k + 1] * s_new; }
                    bf16* yo = YCAT + ((size_t)(b * 4096 + pos)) * DM + 512 + head * 64 + 4 * h;
#pragma unroll
                    for (int gq = 0; gq < 4; ++gq) {
                        u32x2 w0, w1;
                        w0.x = cvtpk(o0[4 * gq], o0[4 * gq + 1]); w0.y = cvtpk(o0[4 * gq + 2], o0[4 * gq + 3]);
                        w1.x = cvtpk(o1[4 * gq], o1[4 * gq + 1]); w1.y = cvtpk(o1[4 * gq + 2], o1[4 * gq + 3]);
                        *(u32x2*)(yo + 8 * gq) = w0; *(u32x2*)(yo + 32 + 8 * gq) = w1;
                    }
                }
            }
        }
        __syncthreads();
    }
}

__device__ __forceinline__ void conv_unit(LAS unsigned char* lds, int b, int tile, const bf16* __restrict__ AV, const bf16* __restrict__ AG, const float* __restrict__ cw,
                                          const float* __restrict__ cb, const float* __restrict__ cg_, const float* __restrict__ cbeta, bf16* YCAT) {
    int tid_ = threadIdx.x; asm volatile("" : "+v"(tid_));
    const int tid = tid_, lane = tid & 63, wid = tid >> 6;
    const int t0 = tile * 32;
    LAS float* u = (LAS float*)lds;
    LAS float* co = (LAS float*)(lds + 63488);
    for (int c = tid; c < 62 * 32; c += NTHR) {
        const int tt = c >> 5, ch = (c & 31) * 8, t = t0 - 30 + tt;
        float uv[8];
        if (t >= 0) {
            const size_t off = ((size_t)(b * 4096 + t)) * 256 + ch;
            const u32x4 vv = *(const u32x4*)(AV + off), gg = *(const u32x4*)(AG + off);
#pragma unroll
            for (int j = 0; j < 4; ++j) {
                const unsigned vw = vv[j], gw = gg[j];
                const float v0 = __builtin_bit_cast(float, vw << 16), v1 = __builtin_bit_cast(float, vw & 0xffff0000u);
                const float g0 = __builtin_bit_cast(float, gw << 16), g1 = __builtin_bit_cast(float, gw & 0xffff0000u);
                uv[2 * j] = v0 * sigmoid_f(g0); uv[2 * j + 1] = v1 * sigmoid_f(g1);
            }
        } else {
#pragma unroll
            for (int j = 0; j < 8; ++j) uv[j] = 0.f;
        }
        *(LAS f32x4*)(u + tt * 256 + ch) = (f32x4){uv[0], uv[1], uv[2], uv[3]};
        *(LAS f32x4*)(u + tt * 256 + ch + 4) = (f32x4){uv[4], uv[5], uv[6], uv[7]};
    }
    const int ch = tid & 255, half = tid >> 8;
    float w[31];
#pragma unroll
    for (int k = 0; k < 31; ++k) w[k] = cw[k * 256 + ch];
    const float bias = cb[ch];
    __syncthreads();
    float uu[46];
#pragma unroll
    for (int i = 0; i < 46; ++i) uu[i] = u[(half * 16 + i) * 256 + ch];
#pragma unroll
    for (int j = 0; j < 16; ++j) {
        float acc = bias;
#pragma unroll
        for (int k = 0; k < 31; ++k) acc += w[k] * uu[j + k];
        co[(half * 16 + j) * 256 + ch] = acc;
    }
    __syncthreads();
    const f32x4 gv = *(const f32x4*)(cg_ + 4 * lane), bv = *(const f32x4*)(cbeta + 4 * lane);
#pragma unroll
    for (int j = 0; j < 4; ++j) {
        const int tl = wid * 4 + j;
        f32x4 v = *(const LAS f32x4*)(co + tl * 256 + 4 * lane);
        const float mean = wave_sum((v[0] + v[1]) + (v[2] + v[3])) * (1.f / 256.f);
        v = v - mean;
        const float var = wave_sum((v[0] * v[0] + v[1] * v[1]) + (v[2] * v[2] + v[3] * v[3])) * (1.f / 256.f);
        const float rstd = 1.0f / sqrtf(var + LN_EPS);
        float o[4];
#pragma unroll
        for (int e = 0; e < 4; ++e) o[e] = silu_f(v[e] * rstd * gv[e] + bv[e]);
        u32x2 wv; wv.x = cvtpk(o[0], o[1]); wv.y = cvtpk(o[2], o[3]);
        *(u32x2*)(YCAT + ((size_t)(b * 4096 + t0 + tl)) * DM + 4 * lane) = wv;
    }
    __syncthreads();
}

#define XB_TMO      128
#define XB_XCNT(j)  (256  + 64 * (j))
#define XB_XSUB(j)  (1280 + 64 * (j))
#define XB_XGEN(j)  (2304 + 64 * (j))
#define XB_TOP      3328
#define XB_TOPGEN   3392
#define XCD_BAR_WORDS 3456
#define XB_SPIN_CAP (1u << 18)

__device__ __forceinline__ unsigned xb_ld(unsigned* p)              { return __hip_atomic_load(p, __ATOMIC_RELAXED, __HIP_MEMORY_SCOPE_AGENT); }
__device__ __forceinline__ unsigned xb_add(unsigned* p, unsigned v) { return __hip_atomic_fetch_add(p, v, __ATOMIC_RELAXED, __HIP_MEMORY_SCOPE_AGENT); }
__device__ __forceinline__ unsigned xb_xcc_id() { return (unsigned)__builtin_amdgcn_s_getreg((3 << 11) | 20) & 0xFu; }
#define XB_SPIN(cond, bar) do { unsigned _sp = 0; while (cond) { __builtin_amdgcn_s_sleep(1); \
    if ((++_sp & 255u) == 0u) { if (xb_ld(&(bar)[XB_TMO])) break; if (_sp > XB_SPIN_CAP) { atomicAdd(&(bar)[XB_TMO], 1u); break; } } } } while (0)

struct XcdBarrier {
    unsigned* bar; unsigned x;
    volatile LAS unsigned* st;
};

__device__ __forceinline__ XcdBarrier xcd_barrier_post(unsigned* bar, volatile LAS unsigned* st) {
    XcdBarrier b; b.bar = bar; b.x = xb_xcc_id(); b.st = st;
    if (threadIdx.x == 0) (void)xb_add(&bar[XB_XCNT(b.x)], 1u);
    return b;
}
__device__ __forceinline__ void xcd_barrier_complete(unsigned* bar, unsigned x, unsigned& nloc, unsigned& nx) {
    const unsigned G = gridDim.x * gridDim.y * gridDim.z;
    unsigned sum, cnt, mine, sp = 0u;
    for (;;) {
        sum = 0u; cnt = 0u; mine = 0u;
#pragma unroll
        for (unsigned j = 0; j < 16; ++j) { const unsigned c = xb_ld(&bar[XB_XCNT(j)]); sum += c; cnt += (c > 0u) ? 1u : 0u; mine = (j == x) ? c : mine; }
        if (sum == G) break;
        __builtin_amdgcn_s_sleep(1);
        if ((++sp & 255u) == 0u) { if (xb_ld(&bar[XB_TMO])) break; if (sp > XB_SPIN_CAP) { atomicAdd(&bar[XB_TMO], 1u); break; } }
    }
    nloc = mine > 0u ? mine : 1u; nx = cnt > 0u ? cnt : 1u;
}

__device__ __forceinline__ void xcd_barrier(const XcdBarrier& b) {
    asm volatile("s_waitcnt vmcnt(0)" ::: "memory");
    __syncthreads();
    if (threadIdx.x == 0) {
        unsigned* bar = b.bar;
        __builtin_amdgcn_s_waitcnt(0);
        unsigned nloc = b.st[0], nx = b.st[1];
        if (nloc == 0u) { xcd_barrier_complete(bar, b.x, nloc, nx); b.st[0] = nloc; b.st[1] = nx; }
        const unsigned old = xb_add(&bar[XB_XSUB(b.x)], 1u);
        const unsigned gen = old / nloc;
        if (old + 1u == (gen + 1u) * nloc) {
            __builtin_amdgcn_fence(__ATOMIC_RELEASE, "agent");
            asm volatile("s_waitcnt vmcnt(0)" ::: "memory");
            const unsigned og = xb_add(&bar[XB_TOP], 1u);
            const unsigned tg = og / nx;
            if (og + 1u == (tg + 1u) * nx) xb_add(&bar[XB_TOPGEN], 1u);
            else XB_SPIN(xb_ld(&bar[XB_TOPGEN]) == tg, bar);
            __builtin_amdgcn_fence(__ATOMIC_ACQUIRE, "agent");
            xb_add(&bar[XB_XGEN(b.x)], 1u);
            asm volatile("s_waitcnt vmcnt(0)" ::: "memory");
        } else {
            XB_SPIN(xb_ld(&bar[XB_XGEN(b.x)]) == gen, bar);
            __builtin_amdgcn_fence(__ATOMIC_ACQUIRE, "agent");
            asm volatile("s_waitcnt vmcnt(0)" ::: "memory");
        }
    }
    __syncthreads();
}

#ifndef SYNC_REPS
#define SYNC_REPS 1
#endif
#ifndef MIX_REPS
#define MIX_REPS 1
#endif
#ifndef MIX2_LO
#define MIX2_LO 0
#endif
#ifndef MIX2_HI
#define MIX2_HI 1024
#endif
#ifndef G1_REPS
#define G1_REPS 1
#endif
#ifndef G3_REPS
#define G3_REPS 1
#endif
#ifndef PRO_REPS
#define PRO_REPS 1
#endif
#define GSYNC() do { for (int r_ = 0; r_ < SYNC_REPS; ++r_) xcd_barrier(xbar); } while (0)
__global__ void __launch_bounds__(NTHR, 2) hybrid_fwd(Args a) {
    extern __shared__ __attribute__((aligned(16))) unsigned char lds_raw[];
    LAS unsigned char* lds = (LAS unsigned char*)lds_raw;
    cg::grid_group grid = cg::this_grid();
    const int tid = threadIdx.x, G = gridDim.x, bx = blockIdx.x;
    unsigned char* ws = a.ws;
    bf16* HB = (bf16*)(ws + WS_HB); bf16* ACT = (bf16*)(ws + WS_ACT); bf16* YCAT = (bf16*)(ws + WS_YCAT);
    bf16 *AV = (bf16*)(ws + WS_AV), *AG = (bf16*)(ws + WS_AG), *BQ = (bf16*)(ws + WS_BQ), *BK = (bf16*)(ws + WS_BK), *BVT = (bf16*)(ws + WS_BVT), *CQ = (bf16*)(ws + WS_CQ), *CK = (bf16*)(ws + WS_CK),
         *CVT1 = (bf16*)(ws + WS_CVT1), *CVT4 = (bf16*)(ws + WS_CVT4), *CVT16 = (bf16*)(ws + WS_CVT16);
    float* lgf = (float*)(ws + WS_LGF); const float* rope = (const float*)(ws + WS_ROPE);
    unsigned* ctl = (unsigned*)(ws + WS_CTL);
    float* H = a.out;

    if (tid < 2) ((volatile LAS unsigned*)(lds + LDS_MISC + 64))[tid] = 0u;
    for (int r_ = 0; r_ < PRO_REPS; ++r_) prologue(a, lds);
    grid.sync();
    XcdBarrier xbar = xcd_barrier_post(ctl + CW_BAR, (volatile LAS unsigned*)(lds + LDS_MISC + 64));

    for (int l = 0; l < 2; ++l) {
        for (int j = 0; j < 3; ++j) {
            if (j != 1) {
                const int fi = l * 2 + (j >> 1);
                {
                    pg8::Gemm g{HB, (const bf16*)(ws + WS_W1T) + (size_t)fi * 5632 * 1024, MTOK, 2 * DFF, DM};
                    pg8::StaticOrder S; S.init(MTOK, 2 * DFF, G, bx);
                    EpiSwiGLU E{ACT};
                    for (int r_ = 0; r_ < G1_REPS; ++r_) pg8::gemm_phase<EpiSwiGLU, pg8::StaticOrder, true, true>(lds, g, S, E);
                }
                GSYNC();
                {
                    pg8::Gemm g{ACT, (const bf16*)(ws + WS_W2T) + (size_t)fi * 1024 * DFF, MTOK, DM, DFF};
                    pg8::StaticOrder S; S.init(MTOK, DM, G, bx);
                    EpiResid E{(l == 0 && j == 0) ? a.x : (const float*)H, H, 0.5f};
#ifndef NO_G2
                    pg8::gemm_phase<EpiResid, pg8::StaticOrder, true, true>(lds, g, S, E);
#endif
                }
                GSYNC();
            } else {
                {
                    pg8::Gemm g{HB, (const bf16*)(ws + WS_WINT) + (size_t)l * NPROJ * 1024, MTOK, NPROJ, DM};
                    pg8::StaticOrder S; S.init(MTOK, NPROJ, G, bx);
                    EpiProj E{AV, AG, BQ, BK, BVT, CQ, CK, CVT1, CVT4, CVT16, rope};
                    for (int r_ = 0; r_ < G3_REPS; ++r_) pg8::gemm_phase<EpiProj, pg8::StaticOrder, true, true>(lds, g, S, E);
                }
                GSYNC();
                {
                    LAS int* itemw = (LAS int*)(lds + LDS_MISC);
                    for (int rep = 0; rep < MIX_REPS; ++rep) {
                    const int lo = rep == 0 ? 0 : MIX2_LO, hi = rep == 0 ? 1024 : MIX2_HI;
                    if (rep) grid.sync();
                    for (;;) {
                        __syncthreads();
                        if (tid == 0) *itemw = (int)atomicAdd(ctl + l + 8 * rep, 1u) + lo;
                        __syncthreads();
                        const int it = *itemw;
                        if (it >= hi) break;
                        if (it < 256) { const int qb = 15 - (it >> 4), bhh = it & 15;
#ifndef NO_FOX
 fox_unit(lds, bhh >> 2, bhh & 3, qb, BQ, BK, BVT, lgf, YCAT);
#endif
 }
                        else if (it < 512) { const int q = it - 256;
#ifndef NO_DIL
 dil_unit(lds, q >> 6, (q >> 3) & 7, q & 7, CQ, CK, CVT1, CVT4, CVT16, YCAT);
#endif
 }
                        else { const int q = it - 512;
#ifndef NO_CONV
 conv_unit(lds, q >> 7, q & 127, AV, AG, a.conv_w + (size_t)l * 31 * 256, a.conv_b + l * 256, a.conv_g + l * 256, a.conv_beta + l * 256, YCAT);
#endif
 }
                    }
                    }
                }
                GSYNC();
                {
                    pg8::Gemm g{YCAT, (const bf16*)(ws + WS_WOT) + (size_t)l * 1024 * 1024, MTOK, DM, DM};
                    pg8::StaticOrder S; S.init(MTOK, DM, G, bx);
                    EpiResid E{(const float*)H, H, 1.0f};
#ifndef NO_G4
                    pg8::gemm_phase<EpiResid, pg8::StaticOrder, true, true>(lds, g, S, E);
#endif
                }
                GSYNC();
            }
#ifndef NO_LN
            ln_phase(H, HB, a.ln_g + (size_t)(l * 3 + j) * DM, a.ln_b + (size_t)(l * 3 + j) * DM, j == 0, a.w_in + (size_t)l * 1024 * INCOLS, a.fbias + l * 4, lgf, lds);
#endif
            if (!(l == 1 && j == 2)) GSYNC();
        }
    }
}

extern "C" void kernel_launch(void* const* d_in, const int* in_sizes, int n_in, void* d_out, int out_size, void* d_ws, size_t ws_size, hipStream_t stream) {
    static int grid_blocks = 0;
    if (grid_blocks == 0) {
        if (n_in != 12 || out_size != MTOK * DM || ws_size < WS_END) { fprintf(stderr, "kernel_launch: unexpected problem (n_in %d out %d ws %zu)\n", n_in, out_size, ws_size); grid_blocks = -1; return; }
        int dev = 0, cus = 0, per_cu = 0;
        hipGetDevice(&dev);
        hipDeviceGetAttribute(&cus, hipDeviceAttributeMultiprocessorCount, dev);
        if (hipFuncSetAttribute((const void*)hybrid_fwd, hipFuncAttributeMaxDynamicSharedMemorySize, LDS_BYTES) != hipSuccess) { fprintf(stderr, "hipFuncSetAttribute failed\n"); grid_blocks = -1; return; }
        if (hipOccupancyMaxActiveBlocksPerMultiprocessor(&per_cu, (const void*)hybrid_fwd, NTHR, LDS_BYTES) != hipSuccess || per_cu < 1) { fprintf(stderr, "occupancy query failed (%d)\n", per_cu); (void)hipGetLastError(); per_cu = 1; }
        grid_blocks = cus * 1;
    }
    if (grid_blocks < 0) return;
    Args a{};
    a.x = (const float*)d_in[0]; a.w_in = (const float*)d_in[1]; a.w_o = (const float*)d_in[2]; a.fbias = (const float*)d_in[3]; a.conv_w = (const float*)d_in[4]; a.conv_b = (const float*)d_in[5];
    a.conv_g = (const float*)d_in[6]; a.conv_beta = (const float*)d_in[7]; a.ffn_w_in = (const float*)d_in[8]; a.ffn_w_out = (const float*)d_in[9]; a.ln_g = (const float*)d_in[10]; a.ln_b = (const float*)d_in[11];
    a.out = (float*)d_out; a.ws = (unsigned char*)d_ws;
    void* args[] = {&a};
    hipError_t e = hipLaunchCooperativeKernel((const void*)hybrid_fwd, dim3(grid_blocks), dim3(NTHR), args, LDS_BYTES, stream);
    if (e != hipSuccess) fprintf(stderr, "cooperative launch failed: %s (grid %d)\n", hipGetErrorString(e), grid_blocks);
}
```
